# Optimizing an MI355X kernel written in HIP

```python
import jax, jax.numpy as jnp
from jax import lax
import numpy as np

D_MODEL = 2048
BATCH = 2
SEQ = 16384
DEPTH = 1

CONV_GROUPS = 8
CONV_GROUP_DIM = 128
CONV_DIM = CONV_GROUPS * CONV_GROUP_DIM
CONV_K = 3
MLA_HEADS = 8
QK_NOPE = 128
QK_ROPE = 64
QK_HEAD = QK_NOPE + QK_ROPE
V_HEAD = 128
MLA_DIM = MLA_HEADS * V_HEAD
D_MIX = CONV_DIM + MLA_DIM
Q_LORA = 768
KV_LORA = 512
D_IN = 3 * CONV_DIM + Q_LORA + KV_LORA + QK_ROPE
ROPE_THETA = 10000.0
N_EXPERTS = 32
TOP_K = 4
D_EXPERT = D_MODEL
SWIGLU_LIMIT = 7.0
SWIGLU_ALPHA = 1.702
MOE_BLOCK = 256
Q_BLOCK = 128
K_BLOCK = 128
EPS = 1e-6

kernel_name = "hymba_conv_mla_adaln_moe_layer"


def rms_norm(x, g):
    xf = x.astype(jnp.float32)
    y = xf * lax.rsqrt(jnp.mean(xf * xf, axis=-1, keepdims=True) + EPS)
    return (y * g.astype(jnp.float32)).astype(x.dtype)


def group_rms_norm(x, g, n_groups):
    shp = x.shape
    xg = x.reshape(shp[:-1] + (n_groups, shp[-1] // n_groups))
    return rms_norm(xg, g.reshape(n_groups, -1)).reshape(shp)


def apply_rope(x, pos):
    half = QK_ROPE // 2
    inv_freq = ROPE_THETA ** (-jnp.arange(half, dtype=jnp.float32) / half)
    ang = pos.astype(jnp.float32)[:, :, None, None] * inv_freq
    cos, sin = jnp.cos(ang), jnp.sin(ang)
    xf = x.astype(jnp.float32)
    x1, x2 = xf[..., :half], xf[..., half:]
    return jnp.concatenate([x1 * cos - x2 * sin, x2 * cos + x1 * sin], axis=-1).astype(x.dtype)


def causal_dwconv(u, w):
    return lax.conv_general_dilated(
        u, w[:, None, :].astype(u.dtype), window_strides=(1,),
        padding=[(CONV_K - 1, 0)], dimension_numbers=('NWC', 'WIO', 'NWC'),
        feature_group_count=u.shape[-1])


def causal_block_attention(q, k, v):
    B, S, H, Dq = q.shape
    Dv = v.shape[-1]
    nq = S // Q_BLOCK
    scale = Dq ** -0.5
    qb = q.reshape(B, nq, Q_BLOCK, H, Dq).transpose(1, 0, 2, 3, 4)

    def one_block(args):
        i, qblk = args
        q_pos = i * Q_BLOCK + jnp.arange(Q_BLOCK)
        qf = qblk.astype(jnp.float32) * scale

        def body(j, carry):
            m, l, acc = carry
            kblk = lax.dynamic_slice_in_dim(k, j * K_BLOCK, K_BLOCK, axis=1).astype(jnp.float32)
            vblk = lax.dynamic_slice_in_dim(v, j * K_BLOCK, K_BLOCK, axis=1).astype(jnp.float32)
            s = jnp.einsum('bqhd,bkhd->bhqk', qf, kblk)
            k_pos = j * K_BLOCK + jnp.arange(K_BLOCK)
            s = jnp.where(k_pos[None, :] <= q_pos[:, None], s, -jnp.inf)
            m_new = jnp.maximum(m, s.max(axis=-1))
            p = jnp.exp(s - m_new[..., None])
            corr = jnp.exp(m - m_new)
            l = l * corr + p.sum(axis=-1)
            acc = acc * corr[..., None] + jnp.einsum('bhqk,bkhd->bhqd', p, vblk)
            return m_new, l, acc

        init = (jnp.full((B, H, Q_BLOCK), -jnp.inf, jnp.float32),
                jnp.zeros((B, H, Q_BLOCK), jnp.float32),
                jnp.zeros((B, H, Q_BLOCK, Dv), jnp.float32))
        n_kv = ((i + 1) * Q_BLOCK + K_BLOCK - 1) // K_BLOCK
        m, l, acc = lax.fori_loop(0, n_kv, body, init)
        out = acc / l[..., None]
        return out.transpose(0, 2, 1, 3).astype(q.dtype)

    out = lax.map(one_block, (jnp.arange(nq), qb))
    return out.transpose(1, 0, 2, 3, 4).reshape(B, S, H, Dv)


def hybrid_mixer(h, positions, w_in, conv_w, q_lat_norm_g, w_uq, kv_lat_norm_g, w_ukv,
                 q_head_norm_g, k_head_norm_g, conv_out_norm_g, mla_out_norm_g, w_out):
    B, S, _ = h.shape
    proj = jnp.einsum('bsd,de->bse', h, w_in)
    splits = [CONV_DIM, 2 * CONV_DIM, 3 * CONV_DIM, 3 * CONV_DIM + Q_LORA,
              3 * CONV_DIM + Q_LORA + KV_LORA]
    b_gate, c_gate, u, q_lat, kv_lat, k_pe = jnp.split(proj, splits, axis=-1)

    y_conv = b_gate * causal_dwconv(c_gate * u, conv_w)

    q = jnp.einsum('bsr,re->bse', rms_norm(q_lat, q_lat_norm_g), w_uq)
    q = q.reshape(B, S, MLA_HEADS, QK_HEAD)
    kv = jnp.einsum('bsr,re->bse', rms_norm(kv_lat, kv_lat_norm_g), w_ukv)
    kv = kv.reshape(B, S, MLA_HEADS, QK_NOPE + V_HEAD)
    k_nope, v = kv[..., :QK_NOPE], kv[..., QK_NOPE:]
    k_pe = jnp.broadcast_to(k_pe[:, :, None, :], (B, S, MLA_HEADS, QK_ROPE))
    k = jnp.concatenate([k_nope, k_pe], axis=-1)
    q = rms_norm(q, q_head_norm_g)
    k = rms_norm(k, k_head_norm_g)
    q = jnp.concatenate([q[..., :QK_NOPE], apply_rope(q[..., QK_NOPE:], positions)], axis=-1)
    k = jnp.concatenate([k[..., :QK_NOPE], apply_rope(k[..., QK_NOPE:], positions)], axis=-1)
    y_mla = causal_block_attention(q, k, v).reshape(B, S, MLA_DIM)

    mixed = jnp.concatenate([group_rms_norm(y_conv, conv_out_norm_g, CONV_GROUPS),
                             group_rms_norm(y_mla, mla_out_norm_g, MLA_HEADS)], axis=-1)
    return jnp.einsum('bse,ed->bsd', mixed, w_out)


def moe_ffn(h, router_w, router_b, w_gate_up, b_gate_up, w_down, b_down):
    T, D = h.shape
    logits = (jnp.einsum('td,de->te', h, router_w) + router_b).astype(jnp.float32)
    top_v, top_i = lax.top_k(logits, TOP_K)
    gates = jax.nn.softmax(top_v, axis=-1)

    TK = T * TOP_K
    flat_e = top_i.reshape(-1)
    order = jnp.argsort(flat_e)
    sorted_e = flat_e[order]
    tok = (order // TOP_K).astype(jnp.int32)
    counts = jnp.bincount(flat_e, length=N_EXPERTS)
    padded = ((counts + MOE_BLOCK - 1) // MOE_BLOCK) * MOE_BLOCK
    padded_end = jnp.cumsum(padded)
    padded_start = padded_end - padded
    group_start = jnp.cumsum(counts) - counts
    rank = jnp.arange(TK) - group_start[sorted_e]
    dest = padded_start[sorted_e] + rank
    n_blocks = -(-TK // MOE_BLOCK) + N_EXPERTS
    P = n_blocks * MOE_BLOCK
    buf_tok = jnp.zeros((P,), jnp.int32).at[dest].set(tok).reshape(n_blocks, MOE_BLOCK)
    block_start = jnp.arange(n_blocks) * MOE_BLOCK
    block_expert = jnp.minimum(jnp.searchsorted(padded_end, block_start, side='right'),
                               N_EXPERTS - 1)

    def expert_block(args):
        rows, e = args
        xe = h[rows]
        gu = xe @ w_gate_up[e] + b_gate_up[e]
        g, up = gu[:, :D_EXPERT], gu[:, D_EXPERT:]
        g = jnp.minimum(g, SWIGLU_LIMIT)
        up = jnp.clip(up, -SWIGLU_LIMIT, SWIGLU_LIMIT)
        act = (up + 1.0) * g * jax.nn.sigmoid(SWIGLU_ALPHA * g)
        return act @ w_down[e] + b_down[e]

    y_buf = lax.map(expert_block, (buf_tok, block_expert)).reshape(P, D)
    dest_orig = jnp.zeros((TK,), dest.dtype).at[order].set(dest)
    y = y_buf[dest_orig].reshape(T, TOP_K, D)
    return jnp.einsum('tkd,tk->td', y, gates.astype(y.dtype))


def setup_inputs(seed: int = 0) -> dict:
    key = jax.random.key(seed)
    ks = jax.random.split(key, 24)
    f32 = jnp.float32
    L = DEPTH

    def nrm(k, shape, scale):
        return jax.random.normal(k, shape, f32) * scale

    def gain(k, shape):
        return 1.0 + 0.05 * jax.random.normal(k, shape, f32)

    x = nrm(ks[0], (BATCH, SEQ, D_MODEL), 1.0)
    c = nrm(ks[1], (BATCH, D_MODEL), 1.0)
    positions = (jax.random.randint(ks[2], (BATCH, 1), 0, 4096, jnp.int32)
                 + jnp.arange(SEQ, dtype=jnp.int32)[None, :])
    return {
        "x": x,
        "c": c,
        "positions": positions,
        "w_ada": nrm(ks[3], (L, D_MODEL, 6 * D_MODEL), 0.5 * D_MODEL ** -0.5),
        "b_ada": nrm(ks[4], (L, 6 * D_MODEL), 0.02),
        "norm_mix_g": gain(ks[5], (L, D_MODEL)),
        "w_in": nrm(ks[6], (L, D_MODEL, D_IN), D_MODEL ** -0.5),
        "conv_w": nrm(ks[7], (L, CONV_K, CONV_DIM), CONV_K ** -0.5),
        "q_lat_norm_g": gain(ks[8], (L, Q_LORA)),
        "w_uq": nrm(ks[9], (L, Q_LORA, MLA_HEADS * QK_HEAD), Q_LORA ** -0.5),
        "kv_lat_norm_g": gain(ks[10], (L, KV_LORA)),
        "w_ukv": nrm(ks[11], (L, KV_LORA, MLA_HEADS * (QK_NOPE + V_HEAD)), KV_LORA ** -0.5),
        "q_head_norm_g": gain(ks[12], (L, QK_HEAD)),
        "k_head_norm_g": gain(ks[13], (L, QK_HEAD)),
        "conv_out_norm_g": gain(ks[14], (L, CONV_DIM)),
        "mla_out_norm_g": gain(ks[15], (L, MLA_DIM)),
        "w_out": nrm(ks[16], (L, D_MIX, D_MODEL), D_MIX ** -0.5),
        "norm_ffn_g": gain(ks[17], (L, D_MODEL)),
        "router_w": nrm(ks[18], (L, D_MODEL, N_EXPERTS), D_MODEL ** -0.5),
        "router_b": nrm(ks[19], (L, N_EXPERTS), 0.01),
        "w_gate_up": nrm(ks[20], (L, N_EXPERTS, D_MODEL, 2 * D_EXPERT), D_MODEL ** -0.5),
        "b_gate_up": nrm(ks[21], (L, N_EXPERTS, 2 * D_EXPERT), 0.01),
        "w_down": nrm(ks[22], (L, N_EXPERTS, D_EXPERT, D_MODEL), D_EXPERT ** -0.5),
        "b_down": nrm(ks[23], (L, N_EXPERTS, D_MODEL), 0.01),
    }


def reference(x, c, positions, w_ada, b_ada, norm_mix_g, w_in, conv_w, q_lat_norm_g, w_uq,
              kv_lat_norm_g, w_ukv, q_head_norm_g, k_head_norm_g, conv_out_norm_g,
              mla_out_norm_g, w_out, norm_ffn_g, router_w, router_b, w_gate_up, b_gate_up,
              w_down, b_down):
    B, S, D = x.shape
    cond = jax.nn.silu(c)
    for l in range(DEPTH):
        mod = jnp.einsum('bd,de->be', cond, w_ada[l]) + b_ada[l]
        sh_m, sc_m, g_m, sh_f, sc_f, g_f = jnp.split(mod[:, None, :], 6, axis=-1)
        h = rms_norm(x, norm_mix_g[l]) * (1.0 + sc_m) + sh_m
        x = x + g_m * hybrid_mixer(h, positions, w_in[l], conv_w[l], q_lat_norm_g[l], w_uq[l],
                                   kv_lat_norm_g[l], w_ukv[l], q_head_norm_g[l],
                                   k_head_norm_g[l], conv_out_norm_g[l], mla_out_norm_g[l],
                                   w_out[l])
        h = rms_norm(x, norm_ffn_g[l]) * (1.0 + sc_f) + sh_f
        y = moe_ffn(h.reshape(B * S, D), router_w[l], router_b[l], w_gate_up[l], b_gate_up[l],
                    w_down[l], b_down[l])
        x = x + g_f * y.reshape(B, S, D)
    return x
```

```cpp
#include <hip/hip_runtime.h>
#include <cstdio>
#include <cstdint>
#include <cmath>

#ifndef MK_ONE_LAUNCH
#define MK_ONE_LAUNCH 1
#endif

#ifndef PROBE_CVT
#define PROBE_CVT 0
#endif
#ifndef REP_P0
#define REP_P0 1
#endif
#ifndef REP_PROJ
#define REP_PROJ 1
#endif
#ifndef REP_ATT
#define REP_ATT 1
#endif
#ifndef REP_MOE1
#define REP_MOE1 1
#endif
#ifndef REP_MOE2
#define REP_MOE2 1
#endif
#ifndef REP_THIN
#define REP_THIN 1
#endif
#ifndef REP_P8
#define REP_P8 1
#endif
#ifndef REP_P9
#define REP_P9 1
#endif
#ifndef REP_P1
#define REP_P1 REP_THIN
#endif
#ifndef REP_P5
#define REP_P5 REP_THIN
#endif
#ifndef REP_P12
#define REP_P12 REP_THIN
#endif
#ifndef REP_P2
#define REP_P2 REP_PROJ
#endif
#ifndef REP_P4
#define REP_P4 REP_PROJ
#endif
#ifndef REP_P7
#define REP_P7 REP_PROJ
#endif

#define GAS __attribute__((address_space(1)))
#define LAS __attribute__((address_space(3)))
typedef unsigned short bf16;
typedef short bf16x8 __attribute__((ext_vector_type(8)));
typedef short s16x4 __attribute__((ext_vector_type(4)));
typedef float f32x2 __attribute__((ext_vector_type(2)));
typedef float f32x4 __attribute__((ext_vector_type(4)));
typedef float f32x16 __attribute__((ext_vector_type(16)));
typedef unsigned u32x2 __attribute__((ext_vector_type(2)));
typedef unsigned u32x4 __attribute__((ext_vector_type(4)));
typedef GAS unsigned gu32;

constexpr int NB = 2, SEQ = 16384, T = NB * SEQ, DM = 2048;
constexpr int CONVD = 1024, QLORA = 768, KVLORA = 512, ROPE = 64, NOPE = 128, DQK = 192, DV = 128, NH = 8;
constexpr int DIN = 4416, DINP = 4608;
constexpr int C_B = 0, C_C = 1024, C_U = 2048, C_QL = 3072, C_KVL = 3840, C_KPE = 4352;
constexpr int NE = 32, TOPK = 4, FF = 2048;
constexpr int NBLK_MAX = T * TOPK / 256 + NE;
constexpr int PROWS = NBLK_MAX * 256;
constexpr float EPS = 1e-6f;
constexpr int KATT = 96;
constexpr float WSCALE = 64.0f, ASCALE = 2.0f, HSCALE = 2.0f, YSCALE = 32.0f, MSCALE = 4.0f;
constexpr int NPH = 13;

constexpr size_t MiB = 1u << 20;
constexpr size_t WS_CTL = 0, CTL_ZERO_BYTES = 128 * 1024;
constexpr size_t WS_MOD = 1 * MiB;
constexpr size_t WS_BIAS2 = WS_MOD + 128 * 1024;
constexpr size_t WS_BLK = WS_MOD + 256 * 1024;
constexpr size_t WS_ROPE = 2 * MiB;
constexpr size_t WS_RSTD2 = 10 * MiB;
constexpr size_t WS_WR = 3572 * MiB;
constexpr size_t WS_AS2 = 3573 * MiB;
constexpr size_t WS_X1P = 3574 * MiB;
constexpr size_t WS_H2 = 3580 * MiB;
constexpr size_t WS_LATP = 3568 * MiB;
constexpr size_t WS_TOPE = 11 * MiB;
constexpr size_t WS_GATE = 12 * MiB;
constexpr size_t WS_RANK = 13 * MiB;
constexpr size_t WS_ROWGATE = 14 * MiB;
constexpr size_t WS_DEST = 15 * MiB;
constexpr size_t WS_TOKMAP = 15 * MiB + 512 * 1024;
constexpr size_t WS_WIN = 16 * MiB;
constexpr size_t WS_WUQ = 34 * MiB;
constexpr size_t WS_WUKV = 37 * MiB;
constexpr size_t WS_WOUT = 39 * MiB;
constexpr size_t WS_WGU = 48 * MiB;
constexpr size_t WS_WD = 560 * MiB;
constexpr size_t WS_H = 816 * MiB;
constexpr size_t WS_PROJ = 944 * MiB;
constexpr size_t WS_QRAW = 1232 * MiB;
constexpr size_t WS_KVRAW = 1328 * MiB;
constexpr size_t WS_K = 1456 * MiB;
constexpr size_t WS_MIXED = 1552 * MiB;
constexpr size_t WS_X1 = 1680 * MiB;
constexpr size_t WS_HS = 1936 * MiB;
constexpr size_t WS_ACT = 2480 * MiB;
constexpr size_t WS_YBUF = 3024 * MiB;
constexpr size_t WS_END = 3644 * MiB;
constexpr int CW_BAR = 4096;
constexpr int CW_CNT = 16384;

constexpr int RING_BYTES = 131072;
constexpr int LDS_BYTES = 163840;
constexpr int LDSCTL_OFF = LDS_BYTES - 1024, MISC_OFF = LDSCTL_OFF + 320;

__device__ __forceinline__ float bf2f(unsigned short u) { return __builtin_bit_cast(float, (unsigned)u << 16); }
__device__ __forceinline__ unsigned cvtpk(float lo, float hi) { unsigned r; asm volatile("v_cvt_pk_bf16_f32 %0, %1, %2" : "=v"(r) : "v"(lo), "v"(hi)); return r; }
__device__ __forceinline__ float wave_sum(float v) {
#pragma unroll
    for (int o = 1; o < 64; o <<= 1) v += __shfl_xor(v, o);
    return v;
}
__device__ __forceinline__ void unpack8(const bf16x8 v, float* f) {
#pragma unroll
    for (int j = 0; j < 8; ++j) f[j] = bf2f((unsigned short)v[j]);
}
__device__ __forceinline__ bf16x8 pack8f(const float* f) {
    u32x4 w = {cvtpk(f[0], f[1]), cvtpk(f[2], f[3]), cvtpk(f[4], f[5]), cvtpk(f[6], f[7])};
    return __builtin_bit_cast(bf16x8, w);
}
__device__ __forceinline__ unsigned ld_agent(const unsigned* p) { return __hip_atomic_load((unsigned*)p, __ATOMIC_RELAXED, __HIP_MEMORY_SCOPE_AGENT); }

#define XB_TMO      128
#define XB_XCNT(j)  (256  + 64 * (j))
#define XB_XSUB(j)  (1280 + 64 * (j))
#define XB_XGEN(j)  (2304 + 64 * (j))
#define XB_TOP      3328
#define XB_TOPGEN   3392
#define XCD_BAR_WORDS 3456
#define XB_SPIN_CAP (1u << 20)

__device__ __forceinline__ unsigned xb_ld(unsigned* p)              { return __hip_atomic_load(p, __ATOMIC_RELAXED, __HIP_MEMORY_SCOPE_AGENT); }
__device__ __forceinline__ unsigned xb_add(unsigned* p, unsigned v) { return __hip_atomic_fetch_add(p, v, __ATOMIC_RELAXED, __HIP_MEMORY_SCOPE_AGENT); }
__device__ __forceinline__ unsigned xb_xcc_id() { return (unsigned)__builtin_amdgcn_s_getreg((3 << 11) | 20) & 0xFu; }
#define XB_SPIN(cond, bar) do { unsigned _sp = 0; while (cond) { __builtin_amdgcn_s_sleep(1); \
    if ((++_sp & 255u) == 0u) { if (xb_ld(&(bar)[XB_TMO])) break; if (_sp > XB_SPIN_CAP) { atomicAdd(&(bar)[XB_TMO], 1u); break; } } } } while (0)

__device__ __forceinline__ int lane_id() { int l; asm volatile("v_mbcnt_lo_u32_b32 %0, -1, 0\n\tv_mbcnt_hi_u32_b32 %0, -1, %0" : "=v"(l)); return l; }
#define TID_NOW(wave) ((wave) * 64 + lane_id())
struct XcdBarrier { unsigned* bar; unsigned x; volatile LAS unsigned* st; };

__device__ __forceinline__ XcdBarrier xcd_barrier_post(unsigned* bar, volatile LAS unsigned* st, int wave) {
    XcdBarrier b; b.bar = bar; b.x = xb_xcc_id(); b.st = st;
    if (TID_NOW(wave) == 0) (void)xb_add(&bar[XB_XCNT(b.x)], 1u);
    return b;
}
__device__ __forceinline__ void xcd_barrier_complete(unsigned* bar, unsigned x, unsigned& nloc, unsigned& nx) {
    const unsigned G = gridDim.x * gridDim.y * gridDim.z;
    unsigned sum, cnt, mine, sp = 0u;
    for (;;) {
        sum = 0u; cnt = 0u; mine = 0u;
#pragma unroll
        for (unsigned j = 0; j < 16; ++j) { const unsigned c = xb_ld(&bar[XB_XCNT(j)]); sum += c; cnt += (c > 0u) ? 1u : 0u; mine = (j == x) ? c : mine; }
        if (sum == G) break;
        __builtin_amdgcn_s_sleep(1);
        if ((++sp & 255u) == 0u) { if (xb_ld(&bar[XB_TMO])) break; if (sp > XB_SPIN_CAP) { atomicAdd(&bar[XB_TMO], 1u); break; } }
    }
    nloc = mine > 0u ? mine : 1u; nx = cnt > 0u ? cnt : 1u;
}
__device__ __forceinline__ void xcd_barrier(const XcdBarrier& b, int wave) {
    asm volatile("s_waitcnt vmcnt(0)" ::: "memory");
    __syncthreads();
    if (TID_NOW(wave) == 0) {
        unsigned* bar = b.bar;
        __builtin_amdgcn_s_waitcnt(0);
        unsigned nloc = b.st[0], nx = b.st[1];
        if (nloc == 0u) { xcd_barrier_complete(bar, b.x, nloc, nx); b.st[0] = nloc; b.st[1] = nx; }
        const unsigned old = xb_add(&bar[XB_XSUB(b.x)], 1u);
        const unsigned gen = old / nloc;
        if (old + 1u == (gen + 1u) * nloc) {
            __builtin_amdgcn_fence(__ATOMIC_RELEASE, "agent");
            asm volatile("s_waitcnt vmcnt(0)" ::: "memory");
            const unsigned og = xb_add(&bar[XB_TOP], 1u);
            const unsigned tg = og / nx;
            if (og + 1u == (tg + 1u) * nx) xb_add(&bar[XB_TOPGEN], 1u);
            else XB_SPIN(xb_ld(&bar[XB_TOPGEN]) == tg, bar);
            __builtin_amdgcn_fence(__ATOMIC_ACQUIRE, "agent");
            xb_add(&bar[XB_XGEN(b.x)], 1u);
            asm volatile("s_waitcnt vmcnt(0)" ::: "memory");
        } else {
            XB_SPIN(xb_ld(&bar[XB_XGEN(b.x)]) == gen, bar);
            __builtin_amdgcn_fence(__ATOMIC_ACQUIRE, "agent");
            asm volatile("s_waitcnt vmcnt(0)" ::: "memory");
        }
    }
    __syncthreads();
}

namespace pg8 {
constexpr int BM = 256, BK = 64, HALF = 128, HTB = HALF * BK * 2, NXCD = 8, WGM = 8;
__host__ __device__ __forceinline__ int lds_byte(int r, int c) { const int st = (r >> 4) * 2 + (c >> 5), rr = r & 15, cc = c & 31, ob = rr * 64 + cc * 2; return st * 1024 + (ob ^ (((ob >> 9) & 1) << 5)); }
__host__ __device__ __forceinline__ void stage_rc(int b, int& R, int& C) { const int st = b / 1024, sb = b % 1024, swz = sb ^ (((sb >> 9) & 1) << 5); R = (st >> 1) * 16 + swz / 64; C = (st & 1) * 32 + (swz % 64) / 2; }
__host__ __device__ __forceinline__ int perm32(int rho) { const int n = rho >> 4, i = rho & 15; return 8 * (i >> 2) + 4 * n + (i & 3); }

struct Unit { int pm, pn, e; };
struct Gemm { const void* A; const void* Bt; int ldaB; int KB; size_t estride; const unsigned short* rowmap; };

struct TileOrder {
    int nM, nN, nwg, G, c; const int* blk_e; int i0, i1;
    __device__ void init(int nM_, int nN_, int G_, int c_, const int* blk_e_, int i0_ = 0, int i1_ = 0x7fffffff) { nM = nM_; nN = nN_; nwg = nM * nN; G = G_; c = c_; blk_e = blk_e_; i0 = i0_; i1 = i1_; }
    __device__ bool next(int ii, Unit& u) const {
        const int i = ii + i0; if (i >= i1) return false;
        const long L = (long)i * G + c; if (L >= nwg) return false;
        int wgid = (int)L; { const int q = nwg / NXCD, r = nwg % NXCD, xcd = wgid % NXCD, off = wgid / NXCD; wgid = (xcd < r ? xcd * (q + 1) : r * (q + 1) + (xcd - r) * q) + off; }
        const int nig = WGM * nN, gid = wgid / nig, fm = gid * WGM, gsz = (nM - fm) < WGM ? (nM - fm) : WGM;
        u.pm = fm + ((wgid % nig) % gsz); u.pn = (wgid % nig) / gsz;
        u.e = blk_e ? __builtin_amdgcn_readfirstlane((int)ld_agent((const unsigned*)(blk_e + u.pm))) : 0;
        return true;
    }
};

typedef int v8i __attribute__((ext_vector_type(8)));
union Frag { v8i v; bf16x8 q[2]; };
template <bool FP8, bool GATHER, class Epi, class Sched>
__device__ __forceinline__ void gemm_phase(LAS unsigned char* lds, const Gemm g, const Sched& S, const Epi& E, int wave) {
    const int tid = TID_NOW(wave), wid = wave, lane = tid & 63, wr = wid >> 2, wc = wid & 3, fr = lane & 15, fq = lane >> 4;
    const int KB = g.KB, nt = KB / (BK * 2), ldaB = g.ldaB;
    unsigned voffA[2], voffB[2];
#pragma unroll
    for (int i = 0; i < 2; ++i) { int R, C; stage_rc(tid * 16 + i * 8192, R, C); const int Rb = (R & ~31) + perm32(R & 31);
        voffA[i] = (unsigned)(R * ldaB + C * 2); voffB[i] = (unsigned)(Rb * KB + C * 2); }
    const size_t kstep = (size_t)(BK * 2);
    const size_t hstepA = (size_t)HALF * ldaB, hstepB = (size_t)HALF * KB;
    const size_t tstepA = 2 * hstepA, tstepB = 2 * hstepB;
    const unsigned ldsw = (unsigned)wid * 1024u;
    const int aoff = lds_byte(wr * 64 + fr, fq * 8), boff = lds_byte(wc * 32 + fr, fq * 8);
    LAS unsigned short* lt = (LAS unsigned short*)(lds + 8 * HTB);
    unsigned gA0[2] = {0u, 0u}, gA1[2] = {0u, 0u}; int rA[2] = {0, 0}; unsigned cA2[2] = {0u, 0u};
    if constexpr (GATHER) {
        Unit uu;
        for (int i = 0; i < 34 && S.next(i, uu); ++i) { if (tid < 256) lt[i * 256 + tid] = g.rowmap[(size_t)uu.pm * 256 + tid]; }
        __syncthreads();
#pragma unroll
        for (int i = 0; i < 2; ++i) { int R, C; stage_rc(tid * 16 + i * 8192, R, C); rA[i] = R; cA2[i] = (unsigned)(C * 2); }
    }
#define PG8_GOFF(u, hh, i) ((unsigned)lt[(u) * 256 + (hh) * 128 + rA[i]] * (unsigned)ldaB + cA2[i])
#define PG8_SA(b, h) (((b) * 2 + (h)) * HTB)
#define PG8_SB(b, h) ((4 + (b) * 2 + (h)) * HTB)
#define PG8_STAGE(bufoff, gbase, voff) do { _Pragma("unroll") for (int _i = 0; _i < 2; ++_i) \
        __builtin_amdgcn_global_load_lds((const unsigned*)((const char*)(gbase) + (voff)[_i]), (LAS unsigned*)(lds + (bufoff) + ldsw + _i * 8192), 16, 0, 0); } while (0)
#define PG8_LDA(dst, b, h) do { _Pragma("unroll") for (int m = 0; m < 4; ++m) _Pragma("unroll") for (int k = 0; k < 2; ++k) dst[m].q[k] = *(const LAS bf16x8*)(lds + PG8_SA(b, h) + aoff + m * 2048 + k * 1024); } while (0)
#define PG8_LDB(dst, b, h) do { _Pragma("unroll") for (int n = 0; n < 2; ++n) _Pragma("unroll") for (int k = 0; k < 2; ++k) dst[n].q[k] = *(const LAS bf16x8*)(lds + PG8_SB(b, h) + boff + n * 2048 + k * 1024); } while (0)
#define PG8_MMA(ai, bj, At, Bt) do { __builtin_amdgcn_s_setprio(1); _Pragma("unroll") for (int m = 0; m < 4; ++m) _Pragma("unroll") for (int n = 0; n < 2; ++n) { \
        if constexpr (FP8) asm volatile("v_mfma_f32_16x16x128_f8f6f4 %0, %1, %2, %0" : "+v"(acc[ai][bj][m][n]) : "v"(Bt[n].v), "v"(At[m].v));   \
        else { _Pragma("unroll") for (int k = 0; k < 2; ++k) acc[ai][bj][m][n] = __builtin_amdgcn_mfma_f32_16x16x32_bf16(Bt[n].q[k], At[m].q[k], acc[ai][bj][m][n], 0, 0, 0); } } \
        __builtin_amdgcn_s_setprio(0); } while (0)
#define PG8_WAIT_V(n) asm volatile("s_waitcnt vmcnt(" #n ")" ::: "memory")
#define PG8_WAIT_L(n) asm volatile("s_waitcnt lgkmcnt(" #n ")" ::: "memory")
#define PG8_BAR __builtin_amdgcn_s_barrier()
#define PG8_SCHED __builtin_amdgcn_sched_barrier(0)
    Unit cur, nxt; int ui = 0;
    if (!S.next(0, cur)) return;
    f32x4 acc[2][2][4][2];
#pragma unroll
    for (int a = 0; a < 2; ++a)
#pragma unroll
        for (int b = 0; b < 2; ++b)
#pragma unroll
            for (int m = 0; m < 4; ++m)
#pragma unroll
                for (int n = 0; n < 2; ++n) acc[a][b][m][n] = (f32x4){0.f, 0.f, 0.f, 0.f};
    Frag At[4], B0[2], B1[2];
    const char* cA = GATHER ? (const char*)g.A : (const char*)g.A + (size_t)cur.pm * tstepA; const char* cB = (const char*)g.Bt + (size_t)cur.e * g.estride + (size_t)cur.pn * tstepB;
    if constexpr (GATHER) {
#pragma unroll
        for (int i = 0; i < 2; ++i) { gA0[i] = PG8_GOFF(0, 0, i); gA1[i] = PG8_GOFF(0, 1, i); }
        cA = (const char*)g.A;
        PG8_STAGE(PG8_SB(0, 0), cB, voffB); PG8_STAGE(PG8_SB(0, 1), cB + hstepB, voffB); PG8_STAGE(PG8_SA(0, 0), cA, gA0); PG8_STAGE(PG8_SA(0, 1), cA, gA1);
        if (wr == 1) PG8_BAR;
        PG8_WAIT_V(2); PG8_BAR;
        PG8_STAGE(PG8_SB(1, 0), cB + kstep, voffB); PG8_STAGE(PG8_SA(1, 0), cA + kstep, gA0); PG8_STAGE(PG8_SB(1, 1), cB + hstepB + kstep, voffB);
        PG8_WAIT_V(6); PG8_BAR;
    } else {
    PG8_STAGE(PG8_SB(0, 0), cB, voffB); PG8_STAGE(PG8_SB(0, 1), cB + hstepB, voffB); PG8_STAGE(PG8_SA(0, 0), cA, voffA); PG8_STAGE(PG8_SA(0, 1), cA + hstepA, voffA);
    if (wr == 1) PG8_BAR;
    PG8_WAIT_V(2); PG8_BAR;
    PG8_STAGE(PG8_SB(1, 0), cB + kstep, voffB); PG8_STAGE(PG8_SA(1, 0), cA + kstep, voffA); PG8_STAGE(PG8_SB(1, 1), cB + hstepB + kstep, voffB);
    PG8_WAIT_V(6); PG8_BAR;
    }
    for (;;) {
        const bool has_next = S.next(ui + 1, nxt);
        const char* nA = (has_next && !GATHER) ? (const char*)g.A + (size_t)nxt.pm * tstepA : cA;
        const char* nB = has_next ? (const char*)g.Bt + (size_t)nxt.e * g.estride + (size_t)nxt.pn * tstepB : cB;
        for (int t = 0; t < nt; t += 2) {
            const bool last = (t == nt - 2);
            const char* a1 = cA + (size_t)(t + 1) * kstep;
            const char* a2 = last ? nA : cA + (size_t)(t + 2) * kstep; const char* b2 = last ? nB : cB + (size_t)(t + 2) * kstep;
            const char* a3 = a2 + kstep; const char* b3 = b2 + kstep;
            unsigned s0[2] = {0u, 0u}, s1[2] = {0u, 0u};
            if constexpr (GATHER) {
#pragma unroll
                for (int i = 0; i < 2; ++i) { s0[i] = (last && has_next) ? PG8_GOFF(ui + 1, 0, i) : gA0[i]; s1[i] = (last && has_next) ? PG8_GOFF(ui + 1, 1, i) : gA1[i]; } }
            PG8_LDB(B0, 0, 0); PG8_LDB(B1, 0, 1); PG8_SCHED; PG8_LDA(At, 0, 0);
            if constexpr (GATHER) PG8_STAGE(PG8_SA(1, 1), a1, gA1); else PG8_STAGE(PG8_SA(1, 1), a1 + hstepA, voffA);
            PG8_WAIT_V(8); PG8_WAIT_L(0); PG8_BAR; PG8_MMA(0, 0, At, B0); PG8_MMA(0, 1, At, B1); PG8_BAR; PG8_SCHED;
            PG8_LDA(At, 0, 1); PG8_STAGE(PG8_SB(0, 0), b2, voffB); PG8_STAGE(PG8_SB(0, 1), b2 + hstepB, voffB);
            if constexpr (GATHER) PG8_STAGE(PG8_SA(0, 0), a2, s0); else PG8_STAGE(PG8_SA(0, 0), a2, voffA);
            PG8_WAIT_V(8); PG8_WAIT_L(0); PG8_BAR; PG8_MMA(1, 0, At, B0); PG8_MMA(1, 1, At, B1); PG8_BAR; PG8_SCHED;
            PG8_LDB(B0, 1, 0); PG8_LDB(B1, 1, 1); PG8_SCHED; PG8_LDA(At, 1, 0);
            if constexpr (GATHER) PG8_STAGE(PG8_SA(0, 1), a2, s1); else PG8_STAGE(PG8_SA(0, 1), a2 + hstepA, voffA);
            PG8_WAIT_V(8); PG8_WAIT_L(0); PG8_BAR; PG8_MMA(0, 0, At, B0); PG8_MMA(0, 1, At, B1); PG8_BAR; PG8_SCHED;
            PG8_LDA(At, 1, 1); PG8_STAGE(PG8_SB(1, 0), b3, voffB); PG8_STAGE(PG8_SB(1, 1), b3 + hstepB, voffB);
            if constexpr (GATHER) PG8_STAGE(PG8_SA(1, 0), a3, s0); else PG8_STAGE(PG8_SA(1, 0), a3, voffA);
            PG8_WAIT_V(8); PG8_WAIT_L(0); PG8_BAR; PG8_MMA(1, 0, At, B0); PG8_MMA(1, 1, At, B1); PG8_BAR; PG8_SCHED;
        }
        if (wr == 0) PG8_BAR;
        if constexpr (FP8) asm volatile("s_nop 15\n\ts_nop 15" ::: "memory");
        E(acc, cur, wr, wc, fr, fq);
        if (!has_next) break;
#pragma unroll
        for (int a = 0; a < 2; ++a)
#pragma unroll
            for (int b = 0; b < 2; ++b)
#pragma unroll
                for (int m = 0; m < 4; ++m)
#pragma unroll
                    for (int n = 0; n < 2; ++n) acc[a][b][m][n] = (f32x4){0.f, 0.f, 0.f, 0.f};
        cur = nxt; cA = nA; cB = nB; ++ui;
        if constexpr (GATHER) {
#pragma unroll
            for (int i = 0; i < 2; ++i) { gA0[i] = PG8_GOFF(ui, 0, i); gA1[i] = PG8_GOFF(ui, 1, i); } }
        if (wr == 1) PG8_BAR;
    }
    PG8_WAIT_V(0);
    PG8_BAR;
#undef PG8_GOFF
#undef PG8_SA
#undef PG8_SB
#undef PG8_STAGE
#undef PG8_LDA
#undef PG8_LDB
#undef PG8_MMA
#undef PG8_WAIT_V
#undef PG8_WAIT_L
#undef PG8_BAR
#undef PG8_SCHED
}

typedef const f32x4 (&AccRef)[2][2][4][2];
constexpr int NPART = 20;
struct EpiBf16 {
    bf16* O; int ldc; float* parts_out; const float* parts_in; int pofs; int np; float invn;
    __device__ __forceinline__ void operator()(AccRef acc, const Unit& u, int wr, int wc, int fr, int fq) const {
        const int row0 = u.pm * BM + wr * 64 + fr, col0 = u.pn * BM + wc * 32 + 8 * fq;
        if (parts_out && u.pn >= 12 && u.pn < 17) {
#pragma unroll
            for (int ai = 0; ai < 2; ++ai)
#pragma unroll
                for (int m = 0; m < 4; ++m) { float ss = 0.f;
#pragma unroll
                    for (int bj = 0; bj < 2; ++bj)
#pragma unroll
                        for (int n = 0; n < 2; ++n) { const f32x4 v = acc[ai][bj][m][n]; ss += (v[0] * v[0] + v[1] * v[1]) + (v[2] * v[2] + v[3] * v[3]); }
                    ss += __shfl_xor(ss, 16); ss += __shfl_xor(ss, 32);
                    if (fq == 0) parts_out[(size_t)(row0 + ai * HALF + m * 16) * NPART + (u.pn - 12) * 4 + wc] = ss; }
        }
        float scs[2][4];
#pragma unroll
        for (int ai = 0; ai < 2; ++ai)
#pragma unroll
            for (int m = 0; m < 4; ++m) { scs[ai][m] = 1.f;
                if (parts_in) { const float* pp = parts_in + (size_t)(row0 + ai * HALF + m * 16) * NPART + pofs; float ss = 0.f;
                    for (int i = 0; i < np; i += 4) { const f32x4 v = *(const f32x4*)(pp + i); ss += (v[0] + v[1]) + (v[2] + v[3]); }
                    scs[ai][m] = 1.0f / sqrtf(ss * invn + EPS); } }
#pragma unroll
        for (int ai = 0; ai < 2; ++ai)
#pragma unroll
            for (int m = 0; m < 4; ++m) { const int row = row0 + ai * HALF + m * 16; const float sc = scs[ai][m];
                bf16* rowp = O + (size_t)row * ldc + col0;
#pragma unroll
                for (int bj = 0; bj < 2; ++bj) { const f32x4 v0 = acc[ai][bj][m][0] * sc, v1 = acc[ai][bj][m][1] * sc;
                    u32x4 w; w.x = cvtpk(v0[0], v0[1]); w.y = cvtpk(v0[2], v0[3]); w.z = cvtpk(v1[0], v1[1]); w.w = cvtpk(v1[2], v1[3]);
                    *(u32x4*)(rowp + bj * HALF) = w; } }
    }
};
struct EpiResF32 {
    const float* X; bf16* O; const float* gm; float* parts; float sc;
    __device__ __forceinline__ void operator()(AccRef acc, const Unit& u, int wr, int wc, int fr, int fq) const {
        const int row0 = u.pm * BM + wr * 64 + fr, col0 = u.pn * BM + wc * 32 + 8 * fq;
        const float* g = gm + (size_t)((u.pm * BM) / SEQ) * (6 * DM) + col0;
        f32x4 gv[2][2];
#pragma unroll
        for (int bj = 0; bj < 2; ++bj)
#pragma unroll
            for (int n = 0; n < 2; ++n) gv[bj][n] = *(const f32x4*)(g + bj * HALF + 4 * n) * sc;
        float ssv[2][4];
#pragma unroll
        for (int ai = 0; ai < 2; ++ai) {
            f32x4 xv[4][2][2];
#pragma unroll
            for (int m = 0; m < 4; ++m) { const size_t off = (size_t)(row0 + ai * HALF + m * 16) * DM + col0;
#pragma unroll
                for (int bj = 0; bj < 2; ++bj) { xv[m][bj][0] = __builtin_nontemporal_load((const f32x4*)(X + off + bj * HALF)); xv[m][bj][1] = __builtin_nontemporal_load((const f32x4*)(X + off + bj * HALF + 4)); } }
#pragma unroll
            for (int m = 0; m < 4; ++m) { const size_t off = (size_t)(row0 + ai * HALF + m * 16) * DM + col0; float ss = 0.f;
#pragma unroll
                for (int bj = 0; bj < 2; ++bj) {
                    const f32x4 v0 = xv[m][bj][0] + gv[bj][0] * acc[ai][bj][m][0], v1 = xv[m][bj][1] + gv[bj][1] * acc[ai][bj][m][1];
                    ss += ((v0[0] * v0[0] + v0[1] * v0[1]) + (v0[2] * v0[2] + v0[3] * v0[3])) + ((v1[0] * v1[0] + v1[1] * v1[1]) + (v1[2] * v1[2] + v1[3] * v1[3]));
                    u32x4 w; w.x = cvtpk(v0[0], v0[1]); w.y = cvtpk(v0[2], v0[3]); w.z = cvtpk(v1[0], v1[1]); w.w = cvtpk(v1[2], v1[3]);
                    *(u32x4*)(O + off + bj * HALF) = w; }
                ss += __shfl_xor(ss, 16); ss += __shfl_xor(ss, 32); ssv[ai][m] = ss; }
        }
        if (fq == 0) {
#pragma unroll
            for (int ai = 0; ai < 2; ++ai)
#pragma unroll
                for (int m = 0; m < 4; ++m) parts[(size_t)(row0 + ai * HALF + m * 16) * 32 + u.pn * 4 + wc] = ssv[ai][m]; }
    }
};
__device__ __forceinline__ unsigned pk_fp8x4(float a, float b, float c, float d) { int w = __builtin_amdgcn_cvt_pk_fp8_f32(a, b, 0, false); w = __builtin_amdgcn_cvt_pk_fp8_f32(c, d, w, true); return (unsigned)w; }
struct EpiSwiglu {
    unsigned char* O; const float* bgu; float ascale;
    __device__ __forceinline__ void operator()(AccRef acc, const Unit& u, int wr, int wc, int fr, int fq) const {
        const int row0 = u.pm * BM + wr * 64 + fr, col0 = u.pn * HALF + wc * 32 + 8 * fq;
        const float* bp = bgu + (size_t)u.e * (2 * FF) + col0;
        f32x2 bg[4], bu[4];
#pragma unroll
        for (int q = 0; q < 4; ++q) { bg[q] = *(const f32x2*)(bp + 2 * q); bu[q] = *(const f32x2*)(bp + FF + 2 * q); }
        const f32x2 as2 = {ascale, ascale}, c2 = {-1.702f * 1.4426950408889634f, -1.702f * 1.4426950408889634f}, one2 = {1.0f, 1.0f}, sc2 = {ASCALE, ASCALE};
#pragma unroll
        for (int ai = 0; ai < 2; ++ai)
#pragma unroll
            for (int m = 0; m < 4; ++m) { f32x2 r[4];
#pragma unroll
                for (int q = 0; q < 4; ++q) { const int n = q >> 1, i = (q & 1) * 2;
                    f32x2 gt = (f32x2){acc[ai][0][m][n][i], acc[ai][0][m][n][i + 1]} * as2 + bg[q];
                    f32x2 up = (f32x2){acc[ai][1][m][n][i], acc[ai][1][m][n][i + 1]} * as2 + bu[q];
                    gt.x = fminf(gt.x, 7.0f); gt.y = fminf(gt.y, 7.0f);
                    up.x = __builtin_amdgcn_fmed3f(up.x, -7.0f, 7.0f); up.y = __builtin_amdgcn_fmed3f(up.y, -7.0f, 7.0f);
                    const f32x2 ea = gt * c2; f32x2 e; e.x = __builtin_amdgcn_exp2f(ea.x); e.y = __builtin_amdgcn_exp2f(ea.y);
                    const f32x2 den = e + one2; f32x2 sg; sg.x = __builtin_amdgcn_rcpf(den.x); sg.y = __builtin_amdgcn_rcpf(den.y);
                    r[q] = ((up * sc2 + sc2) * gt) * sg; }
                u32x2 w; w.x = pk_fp8x4(r[0].x, r[0].y, r[1].x, r[1].y); w.y = pk_fp8x4(r[2].x, r[2].y, r[3].x, r[3].y);
                *(u32x2*)(O + (size_t)(row0 + ai * HALF + m * 16) * FF + col0) = w; }
    }
};
struct EpiDown {
    unsigned char* O; const float* bd; const float* rowgate; float ascale;
    __device__ __forceinline__ void operator()(AccRef acc, const Unit& u, int wr, int wc, int fr, int fq) const {
        const int row0 = u.pm * BM + wr * 64 + fr, col0 = u.pn * BM + wc * 32 + 8 * fq;
        const float* bp = bd + (size_t)u.e * DM + col0;
        f32x4 bv[2][2];
#pragma unroll
        for (int bj = 0; bj < 2; ++bj)
#pragma unroll
            for (int n = 0; n < 2; ++n) bv[bj][n] = *(const f32x4*)(bp + bj * HALF + 4 * n);
        float gts[2][4];
#pragma unroll
        for (int ai = 0; ai < 2; ++ai)
#pragma unroll
            for (int m = 0; m < 4; ++m) gts[ai][m] = rowgate[row0 + ai * HALF + m * 16];
#pragma unroll
        for (int ai = 0; ai < 2; ++ai)
#pragma unroll
            for (int m = 0; m < 4; ++m) { const int row = row0 + ai * HALF + m * 16; const float gt = gts[ai][m] * YSCALE;
                unsigned char* rowp = O + (size_t)row * DM + col0;
#pragma unroll
                for (int bj = 0; bj < 2; ++bj) { const f32x4 v0 = (acc[ai][bj][m][0] * ascale + bv[bj][0]) * gt, v1 = (acc[ai][bj][m][1] * ascale + bv[bj][1]) * gt;
                    u32x2 w; w.x = pk_fp8x4(v0[0], v0[1], v0[2], v0[3]); w.y = pk_fp8x4(v1[0], v1[1], v1[2], v1[3]);
                    *(u32x2*)(rowp + bj * HALF) = w; } }
    }
};
}

namespace att {
constexpr int KVBLK = 64;
constexpr int SHM_V = 16384, SHM_KN = 16384, SHM_KR = 8192;
constexpr int OFF_V = 0, OFF_KN = 2 * SHM_V, OFF_KR = OFF_KN + 2 * SHM_KN, OFF_WS = OFF_KR + 2 * SHM_KR;
constexpr float QSCALE = 0.07216878364870322f * 1.4426950408889634f;
#define KSWZ(row, colB) ((row) * 256 + ((colB) ^ (((row) & 15) << 4)))
#define SBAR() __builtin_amdgcn_sched_barrier(0)
__device__ __forceinline__ int v_st(int k, int c) { const int kk = (k & ~0xC) | ((k & 4) << 1) | ((k & 8) >> 1); return ((kk >> 3) * 4 + (c >> 5)) * 512 + ((kk & 7) * 32 + (c & 31)) * 2; }
__device__ __forceinline__ int v_rd_base(int lane) { return ((lane & 3) << 3) | (((lane >> 2) & 3) << 6) | (((lane >> 4) & 1) << 5) | (((lane >> 5) & 1) << 8); }
constexpr int v_rd_off(int d0, int ks, int half) { return d0 * 512 + ks * 4096 + half * 2048; }
__device__ __forceinline__ int crow(int r, int hi) { return (r & 3) + 8 * (r >> 2) + 4 * hi; }

__device__ __forceinline__ void mask_tile(f32x16& p0, f32x16& p1, int dq) {
    const float NEG = -__builtin_inff();
#pragma unroll
    for (int r = 0; r < 16; ++r) {
        const int c = (r & 3) + 8 * (r >> 2);
        if (dq - c < 0) p0[r] = NEG;
        if (dq - c - 32 < 0) p1[r] = NEG;
    }
}
template <int KB>
__device__ __forceinline__ void qkt(f32x16& p0, f32x16& p1, const LAS char* lds, int r32, int hi, const bf16x8* qr, const f32x16& negm) {
    p0 = negm; p1 = negm;
    const LAS char* kb[8];
#pragma unroll
    for (int dd = 0; dd < 8; ++dd) kb[dd] = lds + OFF_KN + KB * SHM_KN + KSWZ(r32, (dd * 16 + hi * 8) * 2);
    const LAS char* kr = lds + OFF_KR + KB * SHM_KR + r32 * 128; const int sw = (r32 >> 1) & 7;
    bf16x8 f0[3], f1[3];
#define KLD(d, slot) do { if ((d) < 8) { const LAS char* a_ = kb[(d)]; f0[slot] = *(const LAS bf16x8*)a_; f1[slot] = *(const LAS bf16x8*)(a_ + 32 * 256); } \
        else { const LAS char* a_ = kr + (((((d) - 8) * 2 + hi) ^ sw) << 4); f0[slot] = *(const LAS bf16x8*)a_; f1[slot] = *(const LAS bf16x8*)(a_ + 32 * 128); } } while (0)
    KLD(0, 0); KLD(1, 1); SBAR();
    __builtin_amdgcn_s_setprio(1);
#pragma unroll
    for (int d = 0; d < 12; ++d) {
        if (d + 2 < 12) KLD(d + 2, (d + 2) % 3);
        SBAR();
        p0 = __builtin_amdgcn_mfma_f32_32x32x16_bf16(f0[d % 3], qr[d], p0, 0, 0, 0);
        p1 = __builtin_amdgcn_mfma_f32_32x32x16_bf16(f1[d % 3], qr[d], p1, 0, 0, 0);
        SBAR();
    }
    __builtin_amdgcn_s_setprio(0);
#undef KLD
}
template <int VB, bool PIPE>
__device__ __forceinline__ void pv_tile(f32x16* o, int vb0, bf16x8 pa0, bf16x8 pa1, bf16x8 pa2, bf16x8 pa3) {
#define TRRD(dst, off) asm volatile("ds_read_b64_tr_b16 %0, %1 offset:%2" : "=&v"(dst) : "v"(vb0), "i"(off) : "memory")
#define PV_D0(d0) do { s16x4 l0, l1, l2, l3, h0, h1, h2, h3; constexpr int b_ = OFF_V + VB * SHM_V + v_rd_off(d0, 0, 0); \
        TRRD(l0, b_); TRRD(h0, b_ + 2048); TRRD(l1, b_ + 4096); TRRD(h1, b_ + 6144); TRRD(l2, b_ + 8192); TRRD(h2, b_ + 10240); TRRD(l3, b_ + 12288); TRRD(h3, b_ + 14336); \
        asm volatile("s_waitcnt lgkmcnt(0)" ::: "memory"); SBAR(); \
        o[d0] = __builtin_amdgcn_mfma_f32_32x32x16_bf16(pa0, (bf16x8){l0[0], l0[1], l0[2], l0[3], h0[0], h0[1], h0[2], h0[3]}, o[d0], 0, 0, 0); \
        o[d0] = __builtin_amdgcn_mfma_f32_32x32x16_bf16(pa1, (bf16x8){l1[0], l1[1], l1[2], l1[3], h1[0], h1[1], h1[2], h1[3]}, o[d0], 0, 0, 0); \
        o[d0] = __builtin_amdgcn_mfma_f32_32x32x16_bf16(pa2, (bf16x8){l2[0], l2[1], l2[2], l2[3], h2[0], h2[1], h2[2], h2[3]}, o[d0], 0, 0, 0); \
        o[d0] = __builtin_amdgcn_mfma_f32_32x32x16_bf16(pa3, (bf16x8){l3[0], l3[1], l3[2], l3[3], h3[0], h3[1], h3[2], h3[3]}, o[d0], 0, 0, 0); } while (0)
#define PV_RD(S_, d0) do { constexpr int b_ = OFF_V + VB * SHM_V + v_rd_off(d0, 0, 0); \
        TRRD(S_[0], b_); TRRD(S_[4], b_ + 2048); TRRD(S_[1], b_ + 4096); TRRD(S_[5], b_ + 6144); TRRD(S_[2], b_ + 8192); TRRD(S_[6], b_ + 10240); TRRD(S_[3], b_ + 12288); TRRD(S_[7], b_ + 14336); } while (0)
#define PV_MM(S_, d0) do { \
        o[d0] = __builtin_amdgcn_mfma_f32_32x32x16_bf16(pa0, (bf16x8){S_[0][0], S_[0][1], S_[0][2], S_[0][3], S_[4][0], S_[4][1], S_[4][2], S_[4][3]}, o[d0], 0, 0, 0); \
        o[d0] = __builtin_amdgcn_mfma_f32_32x32x16_bf16(pa1, (bf16x8){S_[1][0], S_[1][1], S_[1][2], S_[1][3], S_[5][0], S_[5][1], S_[5][2], S_[5][3]}, o[d0], 0, 0, 0); \
        o[d0] = __builtin_amdgcn_mfma_f32_32x32x16_bf16(pa2, (bf16x8){S_[2][0], S_[2][1], S_[2][2], S_[2][3], S_[6][0], S_[6][1], S_[6][2], S_[6][3]}, o[d0], 0, 0, 0); \
        o[d0] = __builtin_amdgcn_mfma_f32_32x32x16_bf16(pa3, (bf16x8){S_[3][0], S_[3][1], S_[3][2], S_[3][3], S_[7][0], S_[7][1], S_[7][2], S_[7][3]}, o[d0], 0, 0, 0); } while (0)
    __builtin_amdgcn_s_setprio(1);
    if constexpr (PIPE) {
        s16x4 fa[8], fb[8];
        PV_RD(fa, 0);
        PV_RD(fb, 1); asm volatile("s_waitcnt lgkmcnt(8)" ::: "memory"); SBAR(); PV_MM(fa, 0); SBAR();
        PV_RD(fa, 2); asm volatile("s_waitcnt lgkmcnt(8)" ::: "memory"); SBAR(); PV_MM(fb, 1); SBAR();
        PV_RD(fb, 3); asm volatile("s_waitcnt lgkmcnt(8)" ::: "memory"); SBAR(); PV_MM(fa, 2); SBAR();
        asm volatile("s_waitcnt lgkmcnt(0)" ::: "memory"); SBAR(); PV_MM(fb, 3);
    } else { PV_D0(0); PV_D0(1); PV_D0(2); PV_D0(3); }
    __builtin_amdgcn_s_setprio(0);
#undef PV_RD
#undef PV_MM
#undef PV_D0
#undef TRRD
}

template <int VB>
__device__ __forceinline__ float pv_fused(f32x16* o, int vb0, f32x16& p0, f32x16& p1) {
#define TRRD(dst, off) asm volatile("ds_read_b64_tr_b16 %0, %1 offset:%2" : "=&v"(dst) : "v"(vb0), "i"(off) : "memory")
#define PF_RD(S_, k) do { constexpr int b_ = OFF_V + VB * SHM_V + (k) * 4096; \
        TRRD(S_[0], b_ + v_rd_off(0, 0, 0)); TRRD(S_[4], b_ + v_rd_off(0, 0, 1)); TRRD(S_[1], b_ + v_rd_off(1, 0, 0)); TRRD(S_[5], b_ + v_rd_off(1, 0, 1)); \
        TRRD(S_[2], b_ + v_rd_off(2, 0, 0)); TRRD(S_[6], b_ + v_rd_off(2, 0, 1)); TRRD(S_[3], b_ + v_rd_off(3, 0, 0)); TRRD(S_[7], b_ + v_rd_off(3, 0, 1)); } while (0)
#define PF_MM(S_, PA) do { _Pragma("unroll") for (int d0 = 0; d0 < 4; ++d0) \
        o[d0] = __builtin_amdgcn_mfma_f32_32x32x16_bf16(PA, (bf16x8){S_[d0][0], S_[d0][1], S_[d0][2], S_[d0][3], S_[4 + d0][0], S_[4 + d0][1], S_[4 + d0][2], S_[4 + d0][3]}, o[d0], 0, 0, 0); } while (0)
#define PF_EXP(P, B_, OUT) do { _Pragma("unroll") for (int r = 0; r < 8; ++r) { P[B_ + r] = __builtin_amdgcn_exp2f(P[B_ + r]); ps += P[B_ + r]; } \
        unsigned a0 = cvtpk(P[B_+0], P[B_+1]), a1 = cvtpk(P[B_+2], P[B_+3]); unsigned b0 = cvtpk(P[B_+4], P[B_+5]), b1 = cvtpk(P[B_+6], P[B_+7]); \
        auto r0 = __builtin_amdgcn_permlane32_swap(a0, b0, false, false); auto r1 = __builtin_amdgcn_permlane32_swap(a1, b1, false, false); \
        u32x4 w = {r0[0], r1[0], r0[1], r1[1]}; OUT = __builtin_bit_cast(bf16x8, w); } while (0)
    float ps = 0.f; s16x4 fa[8], fb[8]; bf16x8 pa, pb;
    PF_RD(fa, 0);
    PF_EXP(p0, 0, pa); SBAR();
    PF_RD(fb, 1); asm volatile("s_waitcnt lgkmcnt(8)" ::: "memory"); SBAR();
    __builtin_amdgcn_s_setprio(1); PF_MM(fa, pa); __builtin_amdgcn_s_setprio(0); SBAR();
    PF_EXP(p0, 8, pb); SBAR();
    PF_RD(fa, 2); asm volatile("s_waitcnt lgkmcnt(8)" ::: "memory"); SBAR();
    __builtin_amdgcn_s_setprio(1); PF_MM(fb, pb); __builtin_amdgcn_s_setprio(0); SBAR();
    PF_EXP(p1, 0, pa); SBAR();
    PF_RD(fb, 3); asm volatile("s_waitcnt lgkmcnt(8)" ::: "memory"); SBAR();
    __builtin_amdgcn_s_setprio(1); PF_MM(fa, pa); __builtin_amdgcn_s_setprio(0); SBAR();
    PF_EXP(p1, 8, pb); SBAR();
    asm volatile("s_waitcnt lgkmcnt(0)" ::: "memory"); SBAR();
    __builtin_amdgcn_s_setprio(1); PF_MM(fb, pb); __builtin_amdgcn_s_setprio(0);
#undef PF_EXP
#undef PF_MM
#undef PF_RD
#undef TRRD
    return ps;
}

constexpr int WS_BUF = 90112;
constexpr int WT_WGU1 = 16 * 32, WT_WD1 = 16 * 16, WT1 = NE * WT_WGU1, WT2 = WT1 + NE * WT_WD1;
struct WStream { const float* w_gu; const float* w_down; unsigned char* dgu; unsigned char* dd; int it0, stride, total; int pos;
    const char* isrc; int ish; unsigned char* cdst; };
constexpr int WKSH = 11;
__device__ __forceinline__ void wdecode_src(WStream& W, int it) {
    if (it < WT1) { const int e = it / WT_WGU1, q = it % WT_WGU1, k0 = (q / 32) * 128, n0 = (q % 32) * 128; W.isrc = (const char*)(W.w_gu + (size_t)e * DM * (2 * FF) + (size_t)k0 * (2 * FF) + n0); W.ish = 14; }
    else { const int r = it - WT1, e = r / WT_WD1, q = r % WT_WD1, k0 = (q / 16) * 128, n0 = (q % 16) * 128; W.isrc = (const char*)(W.w_down + (size_t)e * FF * DM + (size_t)k0 * DM + n0); W.ish = 13; }
}
__device__ __forceinline__ void wdecode_dst(WStream& W, int it) {
    if (it < WT1) { const int e = it / WT_WGU1, q = it % WT_WGU1, k0 = (q / 32) * 128, n0 = (q % 32) * 128, drow0 = ((n0 % FF) / 128) * 256 + (n0 / FF) * 128; W.cdst = W.dgu + (size_t)e * (2 * FF) * DM + ((size_t)drow0 << WKSH) + k0; }
    else { const int r = it - WT1, e = r / WT_WD1, q = r % WT_WD1, k0 = (q / 16) * 128, n0 = (q % 16) * 128; W.cdst = W.dd + (size_t)e * DM * FF + ((size_t)n0 << WKSH) + k0; }
}
__device__ __forceinline__ void w_issue(WStream& W, LAS char* lds, int wv, int hi, int r32, int q) {
    const int qq = q < W.total ? q : W.total - 1, j = qq & 3;
    if (j == 0 || q == 0) wdecode_src(W, W.it0 + (qq >> 2) * W.stride);
    const unsigned voff = ((unsigned)(hi + wv * 4) << W.ish) + ((unsigned)r32 << 4);
    const char* b0 = W.isrc + ((size_t)(32 * j) << W.ish); const char* b1 = b0 + ((size_t)2 << W.ish);
    const int la0 = (int)(uintptr_t)lds + WS_BUF + j * 16384 + wv * 2048, la1 = la0 + 1024;
    asm volatile("s_mov_b32 m0, %2\n\ts_nop 0\n\tglobal_load_lds_dwordx4 %0, %1 nt" :: "v"(voff), "s"(b0), "s"(la0) : "memory", "m0");
    asm volatile("s_mov_b32 m0, %2\n\ts_nop 0\n\tglobal_load_lds_dwordx4 %0, %1 nt" :: "v"(voff), "s"(b1), "s"(la1) : "memory", "m0");
}
__device__ __forceinline__ void w_convert(WStream& W, LAS char* lds, int wv, int hi, int r32, int q) {
    const int qq = q < W.total ? q : W.total - 1, j = qq & 3;
    if (j == 0 || q == 0) wdecode_dst(W, W.it0 + (qq >> 2) * W.stride);
    const int on = (wv & 1) * 64 + hi * 32 + r32, oq = wv >> 1;
    const LAS float* scr = (const LAS float*)(lds + WS_BUF + j * 16384 + oq * 4096) + on;
    float f[8];
#pragma unroll
    for (int i = 0; i < 8; ++i) f[i] = scr[i * 128];
    asm volatile("s_waitcnt lgkmcnt(0)" : "+v"(f[0]), "+v"(f[1]), "+v"(f[2]), "+v"(f[3]), "+v"(f[4]), "+v"(f[5]), "+v"(f[6]), "+v"(f[7]));
    typedef short v2s_ __attribute__((ext_vector_type(2)));
    v2s_ q0 = {0, 0}, q1 = {0, 0};
    q0 = __builtin_amdgcn_cvt_scalef32_pk_fp8_f32(q0, f[0], f[1], 1.0f / WSCALE, false); q0 = __builtin_amdgcn_cvt_scalef32_pk_fp8_f32(q0, f[2], f[3], 1.0f / WSCALE, true);
    q1 = __builtin_amdgcn_cvt_scalef32_pk_fp8_f32(q1, f[4], f[5], 1.0f / WSCALE, false); q1 = __builtin_amdgcn_cvt_scalef32_pk_fp8_f32(q1, f[6], f[7], 1.0f / WSCALE, true);
    const u32x2 w = (u32x2){__builtin_bit_cast(unsigned, q0), __builtin_bit_cast(unsigned, q1)};
    const unsigned soff = (unsigned)on << WKSH; unsigned char* sb = W.cdst + 32 * j + oq * 8;
    asm volatile("global_store_dwordx2 %0, %1, %2" :: "v"(soff), "v"(w), "s"(sb) : "memory");
}

struct Tensors { const bf16* Q; const bf16* K; const bf16* V; bf16* O; const float* cs; const float* gq; };

template <bool NOMAX>
__device__ __forceinline__ void attn_unit(const Tensors& X, int b, int h, int qb, LAS char* lds, WStream& W, int wave) {
    int tid = TID_NOW(wave); asm volatile("" : "+v"(tid));
    const int wid = __builtin_amdgcn_readfirstlane(tid >> 6), lane = tid & 63, r32 = lane & 31, hi = lane >> 5;
    bf16x8 qr[12];
    {
        const size_t trow = (size_t)b * SEQ + (size_t)qb * 256 + wid * 32 + r32;
        const bf16* qp = X.Q + trow * 1536 + h * DQK + hi * 8;
#pragma unroll
        for (int d0 = 0; d0 < 12; ++d0) qr[d0] = *(const bf16x8*)(qp + d0 * 16);
        float ss = 0.f;
#pragma unroll
        for (int d0 = 0; d0 < 12; ++d0) { float f[8]; unpack8(qr[d0], f);
#pragma unroll
            for (int j = 0; j < 8; ++j) ss += f[j] * f[j]; }
        ss += __shfl_xor(ss, 32);
        const float rs = __builtin_amdgcn_rsqf(ss * (1.0f / DQK) + EPS) ;
        const float* gq = X.gq + hi * 8;
#pragma unroll
        for (int d0 = 0; d0 < 8; ++d0) { float f[8]; unpack8(qr[d0], f); const f32x4 g0 = *(const f32x4*)(gq + d0 * 16), g1 = *(const f32x4*)(gq + d0 * 16 + 4);
#pragma unroll
            for (int j = 0; j < 4; ++j) { f[j] *= rs * g0[j] * QSCALE; f[4 + j] *= rs * g1[j] * QSCALE; }
            qr[d0] = pack8f(f); }
        const float* csr = X.cs + trow * 64 + hi * 8;
#pragma unroll
        for (int g = 0; g < 2; ++g) {
            float x1[8], x2[8]; unpack8(qr[8 + g], x1); unpack8(qr[10 + g], x2);
            const f32x4 ga0 = *(const f32x4*)(gq + (8 + g) * 16), ga1 = *(const f32x4*)(gq + (8 + g) * 16 + 4), gb0 = *(const f32x4*)(gq + (10 + g) * 16), gb1 = *(const f32x4*)(gq + (10 + g) * 16 + 4);
            const f32x4 c0 = *(const f32x4*)(csr + g * 16), c1 = *(const f32x4*)(csr + g * 16 + 4), s0 = *(const f32x4*)(csr + 32 + g * 16), s1 = *(const f32x4*)(csr + 32 + g * 16 + 4);
            float o1[8], o2[8];
#pragma unroll
            for (int j = 0; j < 8; ++j) { const float ga = j < 4 ? ga0[j & 3] : ga1[j & 3], gb = j < 4 ? gb0[j & 3] : gb1[j & 3], c = j < 4 ? c0[j & 3] : c1[j & 3], s = j < 4 ? s0[j & 3] : s1[j & 3];
                const float a = x1[j] * rs * ga, bb = x2[j] * rs * gb;
                o1[j] = (a * c - bb * s) * QSCALE; o2[j] = (bb * c + a * s) * QSCALE; }
            qr[8 + g] = pack8f(o1); qr[10 + g] = pack8f(o2);
        }
    }
    const int NT = 4 * (qb + 1);
    const int qlo = qb * 256 + wid * 32, qm = qlo + r32 - 4 * hi;
    const int grp = wid >> 2;
    LAS float* al_l = (LAS float*)(lds + OFF_WS) + wid * 64 + 32;
    float l_reg = 0.f; f32x16 o[4] = {};
    f32x16 negm = {};
    const int sr = tid >> 4, sc = (tid & 15) * 8, vst0 = v_st(sr, sc), vst1 = v_st(32 + sr, sc), kws = KSWZ(sr, sc * 2);
    const int krk = tid >> 3, krc = tid & 7, krw = krk * 128 + ((krc ^ ((krk >> 1) & 7)) << 4);
    const int vb0 = (int)(uintptr_t)lds + v_rd_base(lane);
    const bf16* Kg = X.K + (size_t)b * SEQ * 1536 + h * DQK;
    const bf16* Vg = X.V + (size_t)b * SEQ * 2048 + h * 256;
    const int ko0 = sr * 1536 + sc, kro = krk * 1536 + NOPE + krc * 8, vo0 = sr * 2048 + sc;
    bf16x8 st_k0, st_k1, st_kr, st_v0, st_v1;
#define SLOADK(t) do { const bf16* kt_ = Kg + (size_t)(t) * (KVBLK * 1536); \
        st_k0 = *(const bf16x8*)(kt_ + ko0); st_k1 = *(const bf16x8*)(kt_ + ko0 + 32 * 1536); st_kr = *(const bf16x8*)(kt_ + kro); } while (0)
#define SLOADV(t) do { const bf16* vt_ = Vg + (size_t)(t) * (KVBLK * 2048); \
        st_v0 = *(const bf16x8*)(vt_ + vo0); st_v1 = *(const bf16x8*)(vt_ + vo0 + 32 * 2048); } while (0)
#define DSW128(addr, off, val) asm volatile("ds_write_b128 %0, %1 offset:%2" :: "v"(addr), "v"(val), "i"(off))
    const int lbase = (int)(uintptr_t)lds, kwa = lbase + kws, krwa = lbase + OFF_KR + krw, vsa0 = lbase + vst0, vsa1 = lbase + vst1;
#define SWRITEK(bf) do { DSW128(kwa, OFF_KN + (bf) * SHM_KN, st_k0); DSW128(kwa, OFF_KN + (bf) * SHM_KN + 32 * 256, st_k1); DSW128(krwa, (bf) * SHM_KR, st_kr); } while (0)
#define SWRITEV(bf) do { DSW128(vsa0, OFF_V + (bf) * SHM_V, st_v0); DSW128(vsa1, OFF_V + (bf) * SHM_V, st_v1); } while (0)
#define LBAR() do { asm volatile("s_waitcnt lgkmcnt(0)" ::: "memory"); __builtin_amdgcn_s_barrier(); } while (0)
#define PK4(P, B_, OUT) do { unsigned a0 = cvtpk(P[B_+0], P[B_+1]), a1 = cvtpk(P[B_+2], P[B_+3]); \
        unsigned b0 = cvtpk(P[B_+4], P[B_+5]), b1 = cvtpk(P[B_+6], P[B_+7]); \
        auto r0 = __builtin_amdgcn_permlane32_swap(a0, b0, false, false); auto r1 = __builtin_amdgcn_permlane32_swap(a1, b1, false, false); \
        u32x4 w = {r0[0], r1[0], r0[1], r1[1]}; OUT = __builtin_bit_cast(bf16x8, w); } while (0)
    constexpr float THR2 = 11.5f;
    f32x16 p0, p1; bf16x8 pa0, pa1, pa2, pa3; float alpha = 1.f, dsh = 0.f; bool resc = false;
#define TILE_STEP(t, BUF) do { \
          \
        if ((t) + 1 < NT) SWRITEK((BUF) ^ 1); SLOADK((t) + 2 < NT ? (t) + 2 : NT - 1);   \
        SBAR(); qkt<BUF>(p0, p1, lds, r32, hi, qr, negm); \
        { const int kb_ = (t) * KVBLK; if (kb_ + KVBLK - 1 > qlo) mask_tile(p0, p1, qm - kb_); } \
        if constexpr (!NOMAX) { float pmax = p0[0]; _Pragma("unroll") for (int r = 1; r < 16; ++r) pmax = fmaxf(pmax, p0[r]); _Pragma("unroll") for (int r = 0; r < 16; ++r) pmax = fmaxf(pmax, p1[r]); \
          { auto rr = __builtin_amdgcn_permlane32_swap(__float_as_uint(pmax), __float_as_uint(pmax), false, false); pmax = fmaxf(__uint_as_float(rr[0]), __uint_as_float(rr[1])); } \
          if (__all(pmax <= THR2)) { alpha = 1.f; resc = false; dsh = 0.f; } \
          else { dsh = fmaxf(pmax, 0.f); alpha = __builtin_amdgcn_exp2f(-dsh); resc = true; \
              _Pragma("unroll") for (int r = 0; r < 16; ++r) negm[r] -= dsh; } } \
          \
        if ((t) + 1 < NT) SWRITEV((BUF) ^ 1); SLOADV((t) + 2 < NT ? (t) + 2 : NT - 1); \
        if (W.pos < W.total + 3) {   \
            asm volatile("s_waitcnt vmcnt(12)" ::: "memory");   \
            if (W.pos >= 3) w_convert(W, lds, wid, hi, r32, W.pos - 3); \
            w_issue(W, lds, wid, hi, r32, W.pos); ++W.pos; } \
        if constexpr (NOMAX) { SBAR(); float ps = pv_fused<BUF>(o, vb0, p0, p1); \
          { auto rr = __builtin_amdgcn_permlane32_swap(__float_as_uint(ps), __float_as_uint(ps), false, false); ps = __uint_as_float(rr[0]) + __uint_as_float(rr[1]); } \
          l_reg += ps; } \
        else { \
        if (resc) { _Pragma("unroll") for (int r = 0; r < 16; ++r) { p0[r] -= dsh; p1[r] -= dsh; } } \
        _Pragma("unroll") for (int r = 0; r < 16; ++r) { p0[r] = __builtin_amdgcn_exp2f(p0[r]); p1[r] = __builtin_amdgcn_exp2f(p1[r]); } \
        { float ps = 0.f; _Pragma("unroll") for (int r = 0; r < 16; ++r) ps += p0[r]; _Pragma("unroll") for (int r = 0; r < 16; ++r) ps += p1[r]; \
          { auto rr = __builtin_amdgcn_permlane32_swap(__float_as_uint(ps), __float_as_uint(ps), false, false); ps = __uint_as_float(rr[0]) + __uint_as_float(rr[1]); } \
          l_reg = l_reg * alpha + ps; } \
        if (resc) { if (hi == 0) al_l[r32] = alpha; asm volatile("s_waitcnt lgkmcnt(0)" ::: "memory"); \
            _Pragma("unroll") for (int d_ = 0; d_ < 4; ++d_) _Pragma("unroll") for (int r = 0; r < 16; ++r) o[d_][r] *= al_l[crow(r, hi)]; } \
        PK4(p0, 0, pa0); PK4(p0, 8, pa1); PK4(p1, 0, pa2); PK4(p1, 8, pa3); \
        SBAR(); pv_tile<BUF, false>(o, vb0, pa0, pa1, pa2, pa3); } \
        LBAR(); } while (0)
    SLOADK(0); SLOADV(0); asm volatile("s_waitcnt vmcnt(0)" ::: "memory"); SWRITEK(0); SWRITEV(0);
    SLOADK(1); SLOADV(1);
    LBAR();
    (void)grp;
    for (int t = 0; t < NT; t += 2) {
        TILE_STEP(t, 0);
        TILE_STEP(t + 1, 1);
    }
#undef TILE_STEP
#undef PK4
#undef SLOADK
#undef SLOADV
#undef SWRITEK
#undef SWRITEV
#undef DSW128
    {
        int tz = TID_NOW(wave); asm volatile("" : "+v"(tz));
        const int wid2 = __builtin_amdgcn_readfirstlane(tz >> 6), lane2 = tz & 63, r32b = lane2 & 31, hib = lane2 >> 5;
        LAS float* li2 = (LAS float*)(lds + OFF_WS) + wid2 * 64;
        if (hib == 0) li2[r32b] = l_reg; asm volatile("s_waitcnt lgkmcnt(0)" ::: "memory");
        bf16* Ow = X.O + ((size_t)b * SEQ + (size_t)qb * 256 + wid2 * 32 + 4 * hib) * 2048 + h * DV + r32b;
#pragma unroll
        for (int r = 0; r < 16; ++r) { const int c0 = (r & 3) + 8 * (r >> 2); const float rli = __builtin_amdgcn_rcpf(li2[c0 + 4 * hib]);
            float v[4]; float sq = 0.f;
#pragma unroll
            for (int d0 = 0; d0 < 4; ++d0) { v[d0] = o[d0][r] * rli; sq += v[d0] * v[d0]; }
#pragma unroll
            for (int off = 1; off < 32; off <<= 1) sq += __shfl_xor(sq, off);
            const float rn = __builtin_amdgcn_rsqf(sq * (1.0f / DV) + EPS);
#pragma unroll
            for (int d0 = 0; d0 < 4; ++d0) { const float vv = v[d0] * rn; const float vn = __shfl_xor(vv, 1);
                if ((r32b & 1) == 0) *(unsigned*)(Ow + (size_t)c0 * 2048 + d0 * 32) = cvtpk(vv, vn); } }

    }
    LBAR();
#undef LBAR
}
#undef KSWZ
#undef SBAR
}

struct Args {
    const float* x; const float* c; const int* pos; const float* w_ada; const float* b_ada; const float* norm_mix_g;
    const float* w_in; const float* conv_w; const float* q_lat_g; const float* w_uq; const float* kv_lat_g; const float* w_ukv;
    const float* q_head_g; const float* k_head_g; const float* conv_out_g; const float* mla_out_g; const float* w_out;
    const float* norm_ffn_g; const float* router_w; const float* router_b; const float* w_gu; const float* b_gu; const float* w_down; const float* b_down;
    float* out; unsigned char* ws;
    float invf[32];
    int ph_lo, ph_hi;
};

constexpr int IT_WIN = 16 * 138, IT_WUQ = 6 * 48, IT_WUKV = 4 * 64, IT_WOUT = 16 * 64, IT_WGU1 = 16 * 128, IT_WD1 = 16 * 64;
constexpr int IT0 = 0, IT1 = IT0 + IT_WIN, IT2 = IT1 + IT_WUQ, IT3 = IT2 + IT_WUKV, IT4 = IT3 + IT_WOUT;
constexpr int LT0 = 0, LT1 = LT0 + NE * IT_WGU1, LT2 = LT1 + NE * IT_WD1;
struct CvtItem { const float* src; int N; int K; int k0; int n0; unsigned char* dst; int drow0; const float* gain; int fp8; };
__device__ __forceinline__ CvtItem cvt_decode_early(const Args& a, int it) {
    CvtItem c; unsigned char* ws = a.ws; c.fp8 = 0; c.gain = nullptr;
    if (it < IT1) { const int r = it - IT0; c.src = a.w_in; c.N = DIN; c.K = DM; c.k0 = (r / 138) * 128; c.n0 = (r % 138) * 32; c.dst = ws + WS_WIN; }
    else if (it < IT2) { const int r = it - IT1; c.src = a.w_uq; c.N = NH * DQK; c.K = QLORA; c.k0 = (r / 48) * 128; c.n0 = (r % 48) * 32; c.dst = ws + WS_WUQ; c.gain = a.q_lat_g; }
    else if (it < IT3) { const int r = it - IT2; c.src = a.w_ukv; c.N = NH * 256; c.K = KVLORA; c.k0 = (r / 64) * 128; c.n0 = (r % 64) * 32; c.dst = ws + WS_WUKV; c.gain = a.kv_lat_g; }
    else { const int r = it - IT3; c.src = a.w_out; c.N = DM; c.K = DM; c.k0 = (r / 64) * 128; c.n0 = (r % 64) * 32; c.dst = ws + WS_WOUT; c.gain = c.k0 < CONVD ? a.conv_out_g : a.mla_out_g - CONVD; }
    c.drow0 = c.n0;
    return c;
}
__device__ __forceinline__ CvtItem cvt_decode_late(const Args& a, int it) {
    CvtItem c; unsigned char* ws = a.ws; c.fp8 = 1; c.gain = nullptr;
    if (it < LT1) { const int e = it / IT_WGU1, q = it % IT_WGU1; c.src = a.w_gu + (size_t)e * DM * (2 * FF); c.N = 2 * FF; c.K = DM; c.k0 = (q / 128) * 128; c.n0 = (q % 128) * 32;
        c.dst = ws + WS_WGU + (size_t)e * (2 * FF) * DM; c.drow0 = ((c.n0 % FF) / 128) * 256 + (c.n0 / FF) * 128 + (c.n0 % 128); }
    else { const int r = it - LT1, e = r / IT_WD1, q = r % IT_WD1; c.src = a.w_down + (size_t)e * FF * DM; c.N = DM; c.K = FF; c.k0 = (q / 64) * 128; c.n0 = (q % 64) * 32;
        c.dst = ws + WS_WD + (size_t)e * DM * FF; c.drow0 = c.n0; }
    return c;
}
template <bool LATE, int MODE = 0>
__device__ __forceinline__ void cvt_wave(const Args& a, LAS float* scr, int lane, int it0, int itend, int stride) {
    const int lr = lane >> 3, lc = (lane & 7) * 4;
    const int on = lane >> 1, oh = lane & 1;
    f32x4 v[16];
    int it = it0;
    if (it < itend) { const CvtItem c = LATE ? cvt_decode_late(a, it) : cvt_decode_early(a, it); const float* sp = c.src + (size_t)(c.k0 + lr) * c.N + c.n0 + lc;
#pragma unroll
        for (int j = 0; j < 16; ++j) v[j] = LATE ? __builtin_nontemporal_load((const f32x4*)(sp + (size_t)(j * 8) * c.N)) : *(const f32x4*)(sp + (size_t)(j * 8) * c.N); }
    while (it < itend) {
        const CvtItem c = LATE ? cvt_decode_late(a, it) : cvt_decode_early(a, it);
        if (MODE == 2) {
#pragma unroll
            for (int j = 0; j < 16; ++j) asm volatile("" :: "v"(v[j]));
            const int nx2 = it + stride;
            if (nx2 < itend) { const CvtItem cn = cvt_decode_late(a, nx2); const float* sp = cn.src + (size_t)(cn.k0 + lr) * cn.N + cn.n0 + lc;
#if PROBE_CVT == 3
                const float* sq = a.w_gu + (size_t)nx2 * 4096 + lane * 4;
#pragma unroll
                for (int j = 0; j < 16; ++j) v[j] = __builtin_nontemporal_load((const f32x4*)(sq + j * 256));
#elif PROBE_CVT == 4
                const float* sq = cn.src + (size_t)((cn.k0 / 4) + (lane >> 5)) * cn.N + (cn.n0 % 1024) * 4 + (lane & 31) * 4;
#pragma unroll
                for (int j = 0; j < 16; ++j) v[j] = __builtin_nontemporal_load((const f32x4*)(sq + (size_t)(j * 2) * cn.N));
#else
#pragma unroll
                for (int j = 0; j < 16; ++j) v[j] = __builtin_nontemporal_load((const f32x4*)(sp + (size_t)(j * 8) * cn.N));
#endif
            }
            it = nx2; continue; }
        if (!LATE && c.gain) {
#pragma unroll
            for (int j = 0; j < 16; ++j) v[j] = v[j] * c.gain[c.k0 + j * 8 + lr]; }
#pragma unroll
        for (int j = 0; j < 16; ++j)
#pragma unroll
            for (int q = 0; q < 4; ++q) scr[(j * 8 + lr) * 33 + lc + q] = v[j][q];
        const int nx = it + stride;
        if (nx < itend) { const CvtItem cn = LATE ? cvt_decode_late(a, nx) : cvt_decode_early(a, nx); const float* sp = cn.src + (size_t)(cn.k0 + lr) * cn.N + cn.n0 + lc;
#pragma unroll
            for (int j = 0; j < 16; ++j) v[j] = LATE ? __builtin_nontemporal_load((const f32x4*)(sp + (size_t)(j * 8) * cn.N)) : *(const f32x4*)(sp + (size_t)(j * 8) * cn.N); }
        asm volatile("s_waitcnt lgkmcnt(0)" ::: "memory");
        if (LATE || c.fp8) {
            unsigned char* dp = c.dst + (size_t)(c.drow0 + on) * c.K + c.k0 + oh * 64;
#pragma unroll
            for (int g = 0; g < 4; ++g) { float f[16];
#pragma unroll
                for (int j = 0; j < 16; ++j) f[j] = scr[(oh * 64 + g * 16 + j) * 33 + on] * WSCALE;
                const u32x4 w = {pg8::pk_fp8x4(f[0], f[1], f[2], f[3]), pg8::pk_fp8x4(f[4], f[5], f[6], f[7]), pg8::pk_fp8x4(f[8], f[9], f[10], f[11]), pg8::pk_fp8x4(f[12], f[13], f[14], f[15])};
                __builtin_nontemporal_store(w, (u32x4*)(dp + g * 16)); }
        } else {
            bf16* dp = (bf16*)c.dst + (size_t)(c.drow0 + on) * c.K + c.k0 + oh * 64;
#pragma unroll
            for (int g = 0; g < 8; ++g) { float f[8];
#pragma unroll
                for (int j = 0; j < 8; ++j) f[j] = scr[(oh * 64 + g * 8 + j) * 33 + on];
                *(bf16x8*)(dp + g * 8) = pack8f(f); }
        }
        asm volatile("s_waitcnt lgkmcnt(0)" ::: "memory");
        it = nx;
    }
}

constexpr int BT_WGU1 = 16 * 16, BT_WD1 = 16 * 8, BT1 = NE * BT_WGU1, BT2 = BT1 + NE * BT_WD1;
struct BItem { const float* src; int N; int K; int k0; int n0; unsigned char* dst; int gu; };
__device__ __forceinline__ BItem bcvt_decode(const Args& a, int it) {
    BItem c; unsigned char* ws = a.ws;
    if (it < BT1) { const int e = it / BT_WGU1, q = it % BT_WGU1; c.src = a.w_gu + (size_t)e * DM * (2 * FF); c.N = 2 * FF; c.K = DM; c.k0 = (q / 16) * 128; c.n0 = (q % 16) * 256; c.dst = ws + WS_WGU + (size_t)e * (2 * FF) * DM; c.gu = 1; }
    else { const int r = it - BT1, e = r / BT_WD1, q = r % BT_WD1; c.src = a.w_down + (size_t)e * FF * DM; c.N = DM; c.K = FF; c.k0 = (q / 8) * 128; c.n0 = (q % 8) * 256; c.dst = ws + WS_WD + (size_t)e * DM * FF; c.gu = 0; }
    return c;
}
__device__ __forceinline__ void bcvt_block(const Args& a, LAS float* scr, int tid, int it0, int itend, int stride) {
    const int wv = tid >> 6, ln = tid & 63;
    const int on = tid >> 1, oh = tid & 1;
    f32x4 va[16], vb[16];
#define BLOAD(V, IT) do { if ((IT) < itend) { const BItem c_ = bcvt_decode(a, (IT)); const float* sp_ = c_.src + (size_t)(c_.k0 + wv) * c_.N + c_.n0 + ln * 4; \
        _Pragma("unroll") for (int j = 0; j < 16; ++j) V[j] = *(const f32x4*)(sp_ + (size_t)(j * 8) * c_.N); } } while (0)
#define BSTEP(V, IT, ITNEXT) do { const BItem c = bcvt_decode(a, (IT)); \
        __syncthreads(); \
        _Pragma("unroll") for (int j = 0; j < 16; ++j) *(LAS f32x4*)(scr + (j * 8 + wv) * 260 + ln * 4) = V[j]; \
        BLOAD(V, ITNEXT); \
        __syncthreads(); \
        const int n = c.n0 + on; \
        const int drow = c.gu ? ((n % FF) / 128) * 256 + (n / FF) * 128 + (n % 128) : n; \
        unsigned char* dp = c.dst + (size_t)drow * c.K + c.k0 + oh * 64; \
        _Pragma("unroll") for (int g = 0; g < 4; ++g) { float f[16]; \
            _Pragma("unroll") for (int j = 0; j < 16; ++j) f[j] = scr[(oh * 64 + g * 16 + j) * 260 + on] * WSCALE; \
            const u32x4 w = {pg8::pk_fp8x4(f[0], f[1], f[2], f[3]), pg8::pk_fp8x4(f[4], f[5], f[6], f[7]), pg8::pk_fp8x4(f[8], f[9], f[10], f[11]), pg8::pk_fp8x4(f[12], f[13], f[14], f[15])}; \
            *(u32x4*)(dp + g * 16) = w; } } while (0)
    int it = it0;
    BLOAD(va, it); BLOAD(vb, it + stride);
    while (it < itend) {
        BSTEP(va, it, it + 2 * stride);
        if (it + stride < itend) BSTEP(vb, it + stride, it + 3 * stride);
        it += 2 * stride;
    }
#undef BLOAD
#undef BSTEP
    __syncthreads();
}

constexpr int DT_WGU1 = 16 * 32, DT_WD1 = 16 * 16, DT1 = NE * DT_WGU1, DT2 = DT1 + NE * DT_WD1;
struct DItem { const float* src; int N; int K; int k0; int n0; unsigned char* dst; int drow0; };
__device__ __forceinline__ DItem dcvt_decode(const Args& a, int it) {
    DItem c; unsigned char* ws = a.ws;
    if (it < DT1) { const int e = it / DT_WGU1, q = it % DT_WGU1; c.src = a.w_gu + (size_t)e * DM * (2 * FF); c.N = 2 * FF; c.K = DM; c.k0 = (q / 32) * 128; c.n0 = (q % 32) * 128;
        c.dst = ws + WS_WGU + (size_t)e * (2 * FF) * DM; c.drow0 = ((c.n0 % FF) / 128) * 256 + (c.n0 / FF) * 128; }
    else { const int r = it - DT1, e = r / DT_WD1, q = r % DT_WD1; c.src = a.w_down + (size_t)e * FF * DM; c.N = DM; c.K = FF; c.k0 = (q / 16) * 128; c.n0 = (q % 16) * 128;
        c.dst = ws + WS_WD + (size_t)e * DM * FF; c.drow0 = c.n0; }
    return c;
}
__device__ __forceinline__ void bcvt_dma(const Args& a, LAS unsigned char* lds, int tid, int it0, int itend, int stride) {
    const int wv = __builtin_amdgcn_readfirstlane(tid >> 6), ln = tid & 63;
    const int on = tid & 127, oq = tid >> 7;
#define DISSUE(IT, BUF) do { const DItem c_ = dcvt_decode(a, (IT)); const float* sp_ = c_.src + (size_t)(c_.k0 + wv * 16 + (ln >> 5)) * c_.N + c_.n0 + (ln & 31) * 4; \
        _Pragma("unroll") for (int i = 0; i < 8; ++i) __builtin_amdgcn_global_load_lds((const unsigned*)(sp_ + (size_t)(2 * i) * c_.N), (LAS unsigned*)(lds + (BUF) * 65536 + (wv * 8 + i) * 1024), 16, 0, 0); } while (0)
    int it = it0, buf = 0; bool first = true;
    if (it < itend) DISSUE(it, 0);
    while (it < itend) {
        const int nx = it + stride; const bool has_next = nx < itend;
        if (has_next) DISSUE(nx, buf ^ 1);
        if (has_next) { if (first) asm volatile("s_waitcnt vmcnt(8)" ::: "memory"); else asm volatile("s_waitcnt vmcnt(10)" ::: "memory"); }
        else asm volatile("s_waitcnt vmcnt(0)" ::: "memory");
        __builtin_amdgcn_s_barrier();
        const DItem c = dcvt_decode(a, it);
        const LAS float* scr = (const LAS float*)(lds + buf * 65536) + (oq * 32) * 128 + on;
        float f[32];
#pragma unroll
        for (int j = 0; j < 32; ++j) f[j] = scr[j * 128] * WSCALE;
        unsigned char* dp = c.dst + (size_t)(c.drow0 + on) * c.K + c.k0 + oq * 32;
        const u32x4 w0 = {pg8::pk_fp8x4(f[0], f[1], f[2], f[3]), pg8::pk_fp8x4(f[4], f[5], f[6], f[7]), pg8::pk_fp8x4(f[8], f[9], f[10], f[11]), pg8::pk_fp8x4(f[12], f[13], f[14], f[15])};
        const u32x4 w1 = {pg8::pk_fp8x4(f[16], f[17], f[18], f[19]), pg8::pk_fp8x4(f[20], f[21], f[22], f[23]), pg8::pk_fp8x4(f[24], f[25], f[26], f[27]), pg8::pk_fp8x4(f[28], f[29], f[30], f[31])};
        *(u32x4*)dp = w0; *(u32x4*)(dp + 16) = w1;
        asm volatile("s_waitcnt lgkmcnt(0)" ::: "memory");
        __builtin_amdgcn_s_barrier();
        it = nx; buf ^= 1; first = false;
    }
#undef DISSUE
    asm volatile("s_waitcnt vmcnt(0)" ::: "memory");
    __builtin_amdgcn_s_barrier();
}

__global__ void __launch_bounds__(512, 2) fwd(Args a) {
    extern __shared__ __attribute__((aligned(16))) unsigned char lds_raw[];
    LAS unsigned char* lds = (LAS unsigned char*)lds_raw;
    volatile LAS unsigned* MISC = (volatile LAS unsigned*)(lds + MISC_OFF);
    const int wave = __builtin_amdgcn_readfirstlane((int)threadIdx.x >> 6);
    const int G = gridDim.x, bid = blockIdx.x;
#define PH_IDS int tid = TID_NOW(wave); asm volatile("" : "+v"(tid)); const int lane = tid & 63; (void)lane;
    const int gw = bid * 8 + wave, NGW = G * 8;
    unsigned char* ws = a.ws;
    gu32* ctl = (gu32*)(ws + WS_CTL);
    { PH_IDS for (int u = tid; u < (LDS_BYTES - LDSCTL_OFF) / 4; u += 512) ((LAS unsigned*)(lds + LDSCTL_OFF))[u] = 0u; }
    __syncthreads();
    const int lo = a.ph_lo, hi = a.ph_hi;
    XcdBarrier bar; bar.bar = (unsigned*)ctl + CW_BAR; bar.x = 0; bar.st = nullptr;
    if (hi - lo > 1) bar = xcd_barrier_post((unsigned*)ctl + CW_BAR, MISC + 8, wave);
#define IN(k) (lo <= (k) && (k) < hi)
#define SEAM(k) do { if (IN(k) && IN((k) + 1)) xcd_barrier(bar, wave); } while (0)

    float* mod = (float*)(ws + WS_MOD);
    float* bias2 = (float*)(ws + WS_BIAS2);
    int* blk_tab = (int*)(ws + WS_BLK);
    float* rope_cs = (float*)(ws + WS_ROPE);
    float* lat_parts = (float*)(ws + WS_LATP);
    float* rstd2 = (float*)(ws + WS_RSTD2);
    int* tope = (int*)(ws + WS_TOPE);
    float* gate = (float*)(ws + WS_GATE);
    int* rank = (int*)(ws + WS_RANK); int* destrow = (int*)(ws + WS_DEST); unsigned short* tokmap = (unsigned short*)(ws + WS_TOKMAP);
    bf16* wr_t = (bf16*)(ws + WS_WR); unsigned* as2 = (unsigned*)(ws + WS_AS2); float* x1parts = (float*)(ws + WS_X1P); unsigned char* h2b = ws + WS_H2;
    float* rowgate = (float*)(ws + WS_ROWGATE);
    bf16* Wt_in = (bf16*)(ws + WS_WIN); bf16* Wt_uq = (bf16*)(ws + WS_WUQ); bf16* Wt_ukv = (bf16*)(ws + WS_WUKV); bf16* Wt_out = (bf16*)(ws + WS_WOUT);
    bf16* Wt_gu = (bf16*)(ws + WS_WGU); bf16* Wt_d = (bf16*)(ws + WS_WD);
    bf16* hbuf = (bf16*)(ws + WS_H); bf16* proj = (bf16*)(ws + WS_PROJ); bf16* qraw = (bf16*)(ws + WS_QRAW); bf16* kvraw = (bf16*)(ws + WS_KVRAW);
    bf16* Kbuf = (bf16*)(ws + WS_K); bf16* mixed = (bf16*)(ws + WS_MIXED); bf16* x1 = (bf16*)(ws + WS_X1);
    unsigned char* hs = ws + WS_HS; unsigned char* actb = ws + WS_ACT; unsigned char* ybuf = ws + WS_YBUF;

    if (IN(0)) for (int rep_ = 0; rep_ < REP_P0; ++rep_) { PH_IDS
        LAS float* red = (LAS float*)lds;
        for (int s = bid; s < 192; s += G) {
            const int j0 = s * 64, dsub = lane >> 4, c4 = (lane & 15) * 4;
            f32x4 a0 = {0.f, 0.f, 0.f, 0.f}, a1 = {0.f, 0.f, 0.f, 0.f};
            const float* wp = a.w_ada + (size_t)(wave * 256 + dsub) * (6 * DM) + j0 + c4;
#pragma unroll 8
            for (int i = 0; i < 64; ++i) { const int d = wave * 256 + 4 * i + dsub; const f32x4 w = *(const f32x4*)(wp + (size_t)(4 * i) * (6 * DM));
                float c0 = a.c[d], c1 = a.c[DM + d]; c0 = c0 / (1.0f + __expf(-c0)); c1 = c1 / (1.0f + __expf(-c1));
                a0 += w * c0; a1 += w * c1; }
#pragma unroll
            for (int k = 0; k < 4; ++k) { a0[k] += __shfl_xor(a0[k], 16); a0[k] += __shfl_xor(a0[k], 32); a1[k] += __shfl_xor(a1[k], 16); a1[k] += __shfl_xor(a1[k], 32); }
            if (lane < 16) {
#pragma unroll
                for (int k = 0; k < 4; ++k) { red[(wave * 2 + 0) * 64 + c4 + k] = a0[k]; red[(wave * 2 + 1) * 64 + c4 + k] = a1[k]; } }
            __syncthreads();
            if (tid < 128) { const int b = tid >> 6, j = tid & 63; float sum = 0.f;
#pragma unroll
                for (int w = 0; w < 8; ++w) sum += red[(w * 2 + b) * 64 + j];
                mod[b * (6 * DM) + j0 + j] = sum + a.b_ada[j0 + j]; }
            __syncthreads();
        }
        { u32x4* z = (u32x4*)(Wt_in + (size_t)DIN * DM); const int n16 = (DINP - DIN) * DM * 2 / 16;
          for (int i = bid * 512 + tid; i < n16; i += G * 512) z[i] = (u32x4){0u, 0u, 0u, 0u}; }
        for (int i = bid * 512 + tid; i < T * 32; i += G * 512) { const int t = i >> 5, f = i & 31;
            const float ang = (float)a.pos[t] * a.invf[f];
            const double rev = (double)ang * 0.15915494309189535; const float fr = (float)(rev - floor(rev));
            rope_cs[(size_t)t * 64 + f] = __builtin_amdgcn_cosf(fr); rope_cs[(size_t)t * 64 + 32 + f] = __builtin_amdgcn_sinf(fr); }
        __syncthreads();
        cvt_wave<false>(a, (LAS float*)lds + wave * (128 * 33), lane, gw, IT4, NGW);
        __syncthreads();
        bcvt_dma(a, lds, tid, bid + KATT * G, DT2, G);
    }
    SEAM(0);

    if (IN(1)) for (int rep_ = 0; rep_ < REP_P1; ++rep_) { PH_IDS
        if (bid == 0) {
            for (int o = wave; o < 64; o += 8) { const int b = o >> 5, e = o & 31; float s = 0.f;
                for (int d = lane; d < DM; d += 64) s += mod[b * (6 * DM) + 3 * DM + d] * a.router_w[(size_t)d * NE + e];
                s = wave_sum(s); if (lane == 0) bias2[o] = s + a.router_b[e]; }
        }
        for (int i = bid * 512 + tid; i < NB * DM; i += G * 512) { const int b = i / DM, d = i % DM; const float* mb = mod + b * (6 * DM);
            const float a2 = a.norm_ffn_g[d] * (1.0f + mb[4 * DM + d]);
            as2[i] = (cvtpk(a2, 0.f) & 0xffffu) | (cvtpk(mb[3 * DM + d], 0.f) << 16);
            for (int e = 0; e < NE; ++e) { const float w = a2 * a.router_w[(size_t)d * NE + e]; const unsigned hi = cvtpk(w, 0.f) & 0xffffu; const float lo = w - bf2f((unsigned short)hi);
                wr_t[((size_t)b * 64 + e) * DM + d] = (bf16)hi; wr_t[((size_t)b * 64 + 32 + e) * DM + d] = (bf16)(cvtpk(lo, 0.f) & 0xffffu); } }
        for (int r0 = gw * 16; r0 < T; r0 += NGW * 16) {
            const int b = r0 / SEQ; const float* mb = mod + b * (6 * DM);
            f32x4 ca[8], cs[8];
#pragma unroll
            for (int j = 0; j < 8; ++j) { const int d = j * 256 + lane * 4; const f32x4 g = *(const f32x4*)(a.norm_mix_g + d), sc = *(const f32x4*)(mb + DM + d);
                ca[j] = g * (sc + 1.0f); cs[j] = *(const f32x4*)(mb + d); }
            for (int r = r0; r < r0 + 16; r += 2) {
                const f32x4* xr = (const f32x4*)(a.x + (size_t)r * DM) + lane; const f32x4* xq = xr + DM / 4;
                f32x4 v[8], u[8]; float ss = 0.f, st = 0.f;
#pragma unroll
                for (int j = 0; j < 8; ++j) { v[j] = xr[64 * j]; u[j] = xq[64 * j]; }
#pragma unroll
                for (int j = 0; j < 8; ++j) { ss += (v[j].x * v[j].x + v[j].y * v[j].y) + (v[j].z * v[j].z + v[j].w * v[j].w); st += (u[j].x * u[j].x + u[j].y * u[j].y) + (u[j].z * u[j].z + u[j].w * u[j].w); }
#pragma unroll
                for (int o = 1; o < 64; o <<= 1) { ss += __shfl_xor(ss, o); st += __shfl_xor(st, o); }
                const float rs = 1.0f / sqrtf(ss * (1.0f / DM) + EPS), rt = 1.0f / sqrtf(st * (1.0f / DM) + EPS);
                u32x2* o8 = (u32x2*)(hbuf + (size_t)r * DM) + lane; u32x2* o9 = o8 + DM / 4;
#pragma unroll
                for (int j = 0; j < 8; ++j) { const f32x4 y = v[j] * rs * ca[j] + cs[j], z = u[j] * rt * ca[j] + cs[j]; o8[64 * j] = (u32x2){cvtpk(y.x, y.y), cvtpk(y.z, y.w)}; o9[64 * j] = (u32x2){cvtpk(z.x, z.y), cvtpk(z.z, z.w)}; }
            }
        }
    }
    SEAM(1);

    if (IN(2)) for (int rep_ = 0; rep_ < REP_P2; ++rep_) {
        pg8::Gemm g{hbuf, Wt_in, DM * 2, DM * 2, 0, nullptr}; pg8::TileOrder S; S.init(T / 256, DINP / 256, G, bid, nullptr);
        pg8::EpiBf16 E{proj, DINP, lat_parts, nullptr, 0, 0, 0.f};
        pg8::gemm_phase<false, false>(lds, g, S, E, wave);
    }
    SEAM(2);


    if (IN(4)) for (int rep_ = 0; rep_ < REP_P4; ++rep_) {
        { pg8::Gemm g{proj + C_QL, Wt_uq, DINP * 2, QLORA * 2, 0, nullptr}; pg8::TileOrder S; S.init(T / 256, (NH * DQK) / 256, G, bid, nullptr);
          pg8::EpiBf16 E{qraw, NH * DQK, nullptr, lat_parts, 0, 12, 1.0f / QLORA};
          pg8::gemm_phase<false, false>(lds, g, S, E, wave); }
        { pg8::Gemm g{proj + C_KVL, Wt_ukv, DINP * 2, KVLORA * 2, 0, nullptr}; pg8::TileOrder S; S.init(T / 256, (NH * 256) / 256, G, bid, nullptr);
          pg8::EpiBf16 E{kvraw, NH * 256, nullptr, lat_parts, 12, 8, 1.0f / KVLORA};
          pg8::gemm_phase<false, false>(lds, g, S, E, wave); }
    }
    SEAM(4);

    if (IN(5)) for (int rep_ = 0; rep_ < REP_P5; ++rep_) { PH_IDS
        for (int t0 = gw * 16; t0 < T; t0 += NGW * 16) {
            const int s0 = t0 % SEQ;
            {
                const int c0 = lane * 16;
                float w0[16], w1[16], w2[16], z1[16], z2[16];
#pragma unroll
                for (int q = 0; q < 4; ++q) { const f32x4 a0 = *(const f32x4*)(a.conv_w + c0 + 4 * q), a1 = *(const f32x4*)(a.conv_w + CONVD + c0 + 4 * q), a2 = *(const f32x4*)(a.conv_w + 2 * CONVD + c0 + 4 * q);
#pragma unroll
                    for (int j = 0; j < 4; ++j) { w0[4 * q + j] = a0[j]; w1[4 * q + j] = a1[j]; w2[4 * q + j] = a2[j]; } }
#pragma unroll
                for (int j = 0; j < 16; ++j) { z1[j] = 0.f; z2[j] = 0.f; }
                if (s0 >= 2) {
                    const bf16* p2 = proj + (size_t)(t0 - 2) * DINP; const bf16* p1 = proj + (size_t)(t0 - 1) * DINP;
                    float cg[16], uu[16];
                    unpack8(*(const bf16x8*)(p2 + C_C + c0), cg); unpack8(*(const bf16x8*)(p2 + C_C + c0 + 8), cg + 8); unpack8(*(const bf16x8*)(p2 + C_U + c0), uu); unpack8(*(const bf16x8*)(p2 + C_U + c0 + 8), uu + 8);
#pragma unroll
                    for (int j = 0; j < 16; ++j) z2[j] = cg[j] * uu[j];
                    unpack8(*(const bf16x8*)(p1 + C_C + c0), cg); unpack8(*(const bf16x8*)(p1 + C_C + c0 + 8), cg + 8); unpack8(*(const bf16x8*)(p1 + C_U + c0), uu); unpack8(*(const bf16x8*)(p1 + C_U + c0 + 8), uu + 8);
#pragma unroll
                    for (int j = 0; j < 16; ++j) z1[j] = cg[j] * uu[j];
                }
                for (int t = t0; t < t0 + 16; ++t) {
                    const bf16* pr = proj + (size_t)t * DINP;
                    float bg[16], cg[16], uu[16], y[16];
                    unpack8(*(const bf16x8*)(pr + C_B + c0), bg); unpack8(*(const bf16x8*)(pr + C_B + c0 + 8), bg + 8);
                    unpack8(*(const bf16x8*)(pr + C_C + c0), cg); unpack8(*(const bf16x8*)(pr + C_C + c0 + 8), cg + 8);
                    unpack8(*(const bf16x8*)(pr + C_U + c0), uu); unpack8(*(const bf16x8*)(pr + C_U + c0 + 8), uu + 8);
                    float ss = 0.f;
#pragma unroll
                    for (int j = 0; j < 16; ++j) { const float z0 = cg[j] * uu[j]; y[j] = bg[j] * (w0[j] * z2[j] + w1[j] * z1[j] + w2[j] * z0); ss += y[j] * y[j]; z2[j] = z1[j]; z1[j] = z0; }
                    ss += __shfl_xor(ss, 1); ss += __shfl_xor(ss, 2); ss += __shfl_xor(ss, 4);
                    const float rs = 1.0f / sqrtf(ss * (1.0f / 128.f) + EPS);
#pragma unroll
                    for (int j = 0; j < 16; ++j) y[j] *= rs;
                    bf16* op = mixed + (size_t)t * DM + c0;
                    *(bf16x8*)op = pack8f(y); *(bf16x8*)(op + 8) = pack8f(y + 8);
                }
            }
            {
                const int hh = lane >> 3, sub = lane & 7;
                float gn[16], ga[4], gb[4];
#pragma unroll
                for (int q = 0; q < 4; ++q) { const f32x4 g4 = *(const f32x4*)(a.k_head_g + sub * 16 + 4 * q);
#pragma unroll
                    for (int j = 0; j < 4; ++j) gn[4 * q + j] = g4[j]; }
                { const f32x4 g4 = *(const f32x4*)(a.k_head_g + NOPE + sub * 4), g5 = *(const f32x4*)(a.k_head_g + NOPE + 32 + sub * 4);
#pragma unroll
                  for (int j = 0; j < 4; ++j) { ga[j] = g4[j]; gb[j] = g5[j]; } }
                for (int t = t0; t < t0 + 16; ++t) {
                    const bf16* kv = kvraw + (size_t)t * 2048 + hh * 256 + sub * 16;
                    const bf16* kp = proj + (size_t)t * DINP + C_KPE;
                    float kn[16]; unpack8(*(const bf16x8*)kv, kn); unpack8(*(const bf16x8*)(kv + 8), kn + 8);
                    const u32x2 wa = *(const u32x2*)(kp + sub * 4), wb = *(const u32x2*)(kp + 32 + sub * 4);
                    float xa[4] = {bf2f(wa.x & 0xffff), bf2f(wa.x >> 16), bf2f(wa.y & 0xffff), bf2f(wa.y >> 16)};
                    float xb[4] = {bf2f(wb.x & 0xffff), bf2f(wb.x >> 16), bf2f(wb.y & 0xffff), bf2f(wb.y >> 16)};
                    float ss = 0.f;
#pragma unroll
                    for (int j = 0; j < 16; ++j) ss += kn[j] * kn[j];
#pragma unroll
                    for (int j = 0; j < 4; ++j) ss += xa[j] * xa[j] + xb[j] * xb[j];
                    ss += __shfl_xor(ss, 1); ss += __shfl_xor(ss, 2); ss += __shfl_xor(ss, 4);
                    const float rs = 1.0f / sqrtf(ss * (1.0f / DQK) + EPS);
                    const f32x4 cc = *(const f32x4*)(rope_cs + (size_t)t * 64 + sub * 4), sn = *(const f32x4*)(rope_cs + (size_t)t * 64 + 32 + sub * 4);
#pragma unroll
                    for (int j = 0; j < 16; ++j) kn[j] *= rs * gn[j];
                    float o1[4], o2[4];
#pragma unroll
                    for (int j = 0; j < 4; ++j) { const float p = xa[j] * rs * ga[j], q = xb[j] * rs * gb[j]; o1[j] = p * cc[j] - q * sn[j]; o2[j] = q * cc[j] + p * sn[j]; }
                    bf16* ko = Kbuf + (size_t)t * 1536 + hh * DQK;
                    *(bf16x8*)(ko + sub * 16) = pack8f(kn); *(bf16x8*)(ko + sub * 16 + 8) = pack8f(kn + 8);
                    *(u32x2*)(ko + NOPE + sub * 4) = (u32x2){cvtpk(o1[0], o1[1]), cvtpk(o1[2], o1[3])};
                    *(u32x2*)(ko + NOPE + 32 + sub * 4) = (u32x2){cvtpk(o2[0], o2[1]), cvtpk(o2[2], o2[3])};
                }
            }
        }
    }
    SEAM(5);

    if (IN(6)) for (int rep_ = 0; rep_ < REP_ATT; ++rep_) {
        const att::Tensors X{qraw, Kbuf, kvraw + 128, mixed + CONVD, rope_cs, a.q_head_g};
        bool att_fast; { const int ln_ = lane_id(); float gq = 0.f, gk = 0.f;
            for (int i = ln_; i < DQK; i += 64) { gq = fmaxf(gq, fabsf(a.q_head_g[i])); gk = fmaxf(gk, fabsf(a.k_head_g[i])); }
#pragma unroll
            for (int o = 1; o < 64; o <<= 1) { gq = fmaxf(gq, __shfl_xor(gq, o)); gk = fmaxf(gk, __shfl_xor(gk, o)); }
            att_fast = __builtin_amdgcn_readfirstlane((int)(20.0f * gq * gk <= 64.0f)) != 0; }
        att::WStream W{a.w_gu, a.w_down, ws + WS_WGU, ws + WS_WD, bid, G, 0, 0, nullptr, 0, nullptr};
        int katt; { const int avail = bid < DT2 ? (DT2 - bid + G - 1) / G : 0; katt = avail < KATT ? avail : KATT; }
        W.total = katt * 4;
        for (int i = bid; i < 512; i += G) {
            const int bh = (i >> 8) * 8 + (i & 7), xq = (i & 255) >> 3;
            for (int u = 0; u < 2; ++u) { if (att_fast) att::attn_unit<true>(X, bh >> 3, bh & 7, u ? xq : 63 - xq, (LAS char*)lds, W, wave); else att::attn_unit<false>(X, bh >> 3, bh & 7, u ? xq : 63 - xq, (LAS char*)lds, W, wave); }
        }
        asm volatile("s_waitcnt vmcnt(0)" ::: "memory");
        __syncthreads();
        { int tz = TID_NOW(wave); asm volatile("" : "+v"(tz));
          int kd = W.pos >= 3 ? (W.pos - 3) >> 2 : 0; kd = kd < katt ? kd : katt;
          bcvt_dma(a, lds, tz, bid + kd * G, (bid + KATT * G < DT2) ? bid + KATT * G : DT2, G); }
    }
    SEAM(6);

    if (IN(7)) for (int rep_ = 0; rep_ < REP_P7; ++rep_) {
        pg8::Gemm g{mixed, Wt_out, DM * 2, DM * 2, 0, nullptr}; pg8::TileOrder S; S.init(T / 256, DM / 256, G, bid, nullptr);
        pg8::EpiResF32 E{a.x, x1, mod + 2 * DM, x1parts, 1.0f};
        pg8::gemm_phase<false, false>(lds, g, S, E, wave);
    }
    SEAM(7);

    if (IN(8)) for (int rep_ = 0; rep_ < REP_P8; ++rep_) { PH_IDS
        const int sh_ = rep_ ? 64 : 0; int* tope_ = rep_ ? (int*)(ws + WS_HS) : tope; float* gate_ = rep_ ? (float*)(ws + WS_HS + MiB) : gate; int* rank_ = rep_ ? (int*)(ws + WS_HS + 2 * MiB) : rank;
        LAS unsigned char* la = lds;
        LAS unsigned char* lb = lds + 32768;
        LAS float* lrs = (LAS float*)(lds + 49152);
        LAS float* lg = lrs + 128;
        LAS int* lcnt = (LAS int*)(lg + 128 * 33);
        const int fr = lane & 15, fq = lane >> 4;
        if (rep_ == 0) for (int i = bid * 512 + tid; i < PROWS / 8; i += G * 512) ((u32x4*)tokmap)[i] = (u32x4){0u, 0u, 0u, 0u};
        for (int blk = bid; blk < T / 128; blk += G) {
            const int tok0 = blk * 128, b = tok0 / SEQ;
            if (tid < 64) lcnt[tid] = 0;
            if (tid < 128) { const float* pp = x1parts + (size_t)(tok0 + tid) * 32; float ss = 0.f;
#pragma unroll
                for (int i = 0; i < 32; i += 4) { const f32x4 v = *(const f32x4*)(pp + i); ss += (v[0] + v[1]) + (v[2] + v[3]); }
                lrs[tid] = 1.0f / sqrtf(ss * (1.0f / DM) + EPS); }
            __syncthreads();
            const int xt = tid >> 2, xp = tid & 3;
            const int wn = tid >> 3, wc8 = tid & 7;
            const float rs_st = lrs[xt];
            const bf16* xsrc = x1 + (size_t)(tok0 + xt) * DM + xp * 16;
            const bf16* wsrc = wr_t + ((size_t)b * 64 + wn) * DM + wc8 * 8;
            const unsigned* asrc = as2 + (size_t)b * DM + xp * 16;
            unsigned char* hdst = h2b + (size_t)(tok0 + xt) * DM + xp * 16;
            const int aw0 = xt * 128 + (((2 * xp) ^ ((xt >> 1) & 7)) << 4), aw1 = xt * 128 + (((2 * xp + 1) ^ ((xt >> 1) & 7)) << 4);
            const int bw = wn * 128 + ((wc8 ^ ((wn >> 1) & 7)) << 4);
            const int arow = (wave * 16 + fr) * 128, asw = ((wave * 16 + fr) >> 1) & 7;
            const int bsw = (fr >> 1) & 7;
            f32x4 acc[4];
#pragma unroll
            for (int i = 0; i < 4; ++i) acc[i] = (f32x4){0.f, 0.f, 0.f, 0.f};
            bf16x8 xa = *(const bf16x8*)xsrc, xb = *(const bf16x8*)(xsrc + 8), wv = *(const bf16x8*)wsrc;
            for (int ch = 0; ch < 32; ++ch) {
                LAS unsigned char* ab = la + (ch & 1) * 16384; LAS unsigned char* bb = lb + (ch & 1) * 8192;
                *(LAS bf16x8*)(ab + aw0) = xa; *(LAS bf16x8*)(ab + aw1) = xb; *(LAS bf16x8*)(bb + bw) = wv;
                if (rep_ == 0) {
                    float xf[16]; unpack8(xa, xf); unpack8(xb, xf + 8);
                    u32x4 hw;
#pragma unroll
                    for (int q = 0; q < 4; ++q) { const u32x4 av = *(const u32x4*)(asrc + ch * 64 + 4 * q); float y[4];
#pragma unroll
                        for (int j = 0; j < 4; ++j) y[j] = (xf[4 * q + j] * rs_st * bf2f((unsigned short)(av[j] & 0xffffu)) + bf2f((unsigned short)(av[j] >> 16))) * HSCALE;
                        hw[q] = pg8::pk_fp8x4(y[0], y[1], y[2], y[3]); }
                    *(u32x4*)(hdst + ch * 64) = hw;
                }
                if (ch + 1 < 32) { xa = *(const bf16x8*)(xsrc + (ch + 1) * 64); xb = *(const bf16x8*)(xsrc + (ch + 1) * 64 + 8); wv = *(const bf16x8*)(wsrc + (ch + 1) * 64); }
                __syncthreads();
#pragma unroll
                for (int ks = 0; ks < 2; ++ks) {
                    const bf16x8 af = *(const LAS bf16x8*)(ab + arow + (((ks * 4 + fq) ^ asw) << 4));
#pragma unroll
                    for (int ng = 0; ng < 4; ++ng) { const bf16x8 bf = *(const LAS bf16x8*)(bb + (ng * 16 + fr) * 128 + (((ks * 4 + fq) ^ bsw) << 4));
                        acc[ng] = __builtin_amdgcn_mfma_f32_16x16x32_bf16(bf, af, acc[ng], 0, 0, 0); }
                }
            }
            { const int tl = wave * 16 + fr; const float rs = lrs[tl];
#pragma unroll
              for (int r = 0; r < 4; ++r) { const int e0 = 4 * fq + r, e1 = 16 + 4 * fq + r;
                  lg[tl * 33 + e0] = (acc[0][r] + acc[2][r]) * rs + bias2[b * NE + e0]; lg[tl * 33 + e1] = (acc[1][r] + acc[3][r]) * rs + bias2[b * NE + e1]; } }
            __syncthreads();
            int te[4], lr[4]; float tv[4];
            if (tid < 128) {
                float v[32];
#pragma unroll
                for (int e = 0; e < 32; ++e) v[e] = lg[tid * 33 + e];
#pragma unroll
                for (int k = 0; k < 4; ++k) { float best = v[0]; int bi = 0;
#pragma unroll
                    for (int e = 1; e < 32; ++e) { if (v[e] > best) { best = v[e]; bi = e; } }
                    te[k] = bi; tv[k] = best;
#pragma unroll
                    for (int e = 0; e < 32; ++e) if (e == bi) v[e] = -__builtin_inff(); }
                float den = 0.f, ex[4];
#pragma unroll
                for (int k = 0; k < 4; ++k) { ex[k] = __expf(tv[k] - tv[0]); den += ex[k]; }
                const float inv = 1.0f / den;
#pragma unroll
                for (int k = 0; k < 4; ++k) { tv[k] = ex[k] * inv; lr[k] = atomicAdd((int*)(lcnt + te[k]), 1); }
            }
            __syncthreads();
            if (tid < 32) lcnt[32 + tid] = (int)__hip_atomic_fetch_add((unsigned*)ctl + CW_CNT + sh_ + tid, (unsigned)lcnt[tid], __ATOMIC_RELAXED, __HIP_MEMORY_SCOPE_AGENT);
            __syncthreads();
            if (tid < 128) { const int t = tok0 + tid;
#pragma unroll
                for (int k = 0; k < 4; ++k) { tope_[t * 4 + k] = te[k]; gate_[t * 4 + k] = tv[k]; rank_[t * 4 + k] = lcnt[32 + te[k]] + lr[k]; } }
            __syncthreads();
        }
    }
    SEAM(8);

    if (IN(9)) for (int rep_ = 0; rep_ < REP_P9; ++rep_) { PH_IDS
        LAS int* ps = (LAS int*)lds;
        if (tid == 0) { int run = 0;
            for (int e = 0; e < NE; ++e) { ps[e] = run; const int c = (int)ld_agent((const unsigned*)ctl + CW_CNT + e); run += ((c + 255) >> 8) << 8; }
            ps[32] = run; }
        __syncthreads();
        if (bid == 0) { const int nblk = ps[32] >> 8;
            for (int r = tid; r < NBLK_MAX; r += 512) { int e = 0;
                for (int q = 1; q < NE; ++q) if (ps[q] <= r * 256) e = q;
                blk_tab[r] = (r < nblk) ? e : 0; }
            if (tid == 0) blk_tab[1023] = nblk; }
        for (int i = (bid * 512 + tid); i < T * TOPK; i += G * 512) { const int d_ = ps[tope[i]] + rank[i]; rowgate[d_] = gate[i]; destrow[i] = d_; tokmap[d_] = (unsigned short)(i >> 2); }
    }
    SEAM(9);

    if (IN(10)) for (int rep_ = 0; rep_ < REP_MOE1; ++rep_) {
        const int nblk = __builtin_amdgcn_readfirstlane((int)ld_agent((const unsigned*)blk_tab + 1023));
        pg8::Gemm g{h2b, Wt_gu, DM, DM, (size_t)(2 * FF) * DM, tokmap}; pg8::TileOrder S; S.init(nblk, (2 * FF) / 256, G, bid, blk_tab);
        pg8::EpiSwiglu E{actb, a.b_gu, 1.0f / (WSCALE * HSCALE)};
        pg8::gemm_phase<true, true>(lds, g, S, E, wave);
    }
    SEAM(10);

    if (IN(11)) for (int rep_ = 0; rep_ < REP_MOE2; ++rep_) {
        const int nblk = __builtin_amdgcn_readfirstlane((int)ld_agent((const unsigned*)blk_tab + 1023));
        pg8::Gemm g{actb, Wt_d, FF, FF, (size_t)DM * FF, nullptr}; pg8::TileOrder S; S.init(nblk, DM / 256, G, bid, blk_tab);
        pg8::EpiDown E{ybuf, a.b_down, rowgate, 1.0f / (WSCALE * ASCALE)};
        pg8::gemm_phase<true, false>(lds, g, S, E, wave);
    }
    SEAM(11);

    if (IN(12)) for (int rep_ = 0; rep_ < REP_P12; ++rep_) { PH_IDS
        for (int t = gw; t < T; t += NGW) {
            const int b = t / SEQ; const float* gf = mod + b * (6 * DM) + 5 * DM;
            int dst[4];
#pragma unroll
            for (int k = 0; k < 4; ++k) dst[k] = destrow[t * 4 + k];
#pragma unroll
            for (int j = 0; j < 4; ++j) { const int d = j * 512 + lane * 8;
                float s[8] = {0.f, 0.f, 0.f, 0.f, 0.f, 0.f, 0.f, 0.f};
#pragma unroll
                for (int k = 0; k < 4; ++k) { const u32x2 w = *(const u32x2*)(ybuf + (size_t)dst[k] * DM + d);
                    const f32x2 f0 = __builtin_amdgcn_cvt_pk_f32_fp8((int)w.x, false), f1 = __builtin_amdgcn_cvt_pk_f32_fp8((int)w.x, true), f2 = __builtin_amdgcn_cvt_pk_f32_fp8((int)w.y, false), f3 = __builtin_amdgcn_cvt_pk_f32_fp8((int)w.y, true);
                    s[0] += f0.x; s[1] += f0.y; s[2] += f1.x; s[3] += f1.y; s[4] += f2.x; s[5] += f2.y; s[6] += f3.x; s[7] += f3.y; }
#pragma unroll
                for (int q = 0; q < 8; ++q) s[q] *= (1.0f / YSCALE);
                float xf[8]; unpack8(*(const bf16x8*)(x1 + (size_t)t * DM + d), xf);
                const f32x4 xa = {xf[0], xf[1], xf[2], xf[3]}, xb = {xf[4], xf[5], xf[6], xf[7]};
                const f32x4 ga = *(const f32x4*)(gf + d), gb = *(const f32x4*)(gf + d + 4);
                *(f32x4*)(a.out + (size_t)t * DM + d) = xa + ga * (f32x4){s[0], s[1], s[2], s[3]};
                *(f32x4*)(a.out + (size_t)t * DM + d + 4) = xb + gb * (f32x4){s[4], s[5], s[6], s[7]}; }
        }
    }
#undef IN
#undef SEAM
}

extern "C" void kernel_launch(void* const* d_in, const int* in_sizes, int n_in, void* d_out, int out_size, void* d_ws, size_t ws_size, hipStream_t stream) {
    static int grid = 0;
    static float invf[32];
    if (grid == 0) {
        if (n_in != 24 || out_size != T * DM || ws_size < WS_END) { fprintf(stderr, "kernel_launch: unexpected shapes (n_in %d out %d ws %zu)\n", n_in, out_size, ws_size); grid = -1; return; }
        int dev = 0, cus = 0;
        if (hipGetDevice(&dev) != hipSuccess || hipDeviceGetAttribute(&cus, hipDeviceAttributeMultiprocessorCount, dev) != hipSuccess) { grid = -1; return; }
        if (hipFuncSetAttribute((const void*)fwd, hipFuncAttributeMaxDynamicSharedMemorySize, LDS_BYTES) != hipSuccess) { fprintf(stderr, "kernel_launch: hipFuncSetAttribute failed\n"); grid = -1; return; }
        int per_cu = 0;
        (void)hipOccupancyMaxActiveBlocksPerMultiprocessor(&per_cu, (const void*)fwd, 512, LDS_BYTES);
        (void)hipGetLastError();
        if (per_cu < 1) fprintf(stderr, "kernel_launch: occupancy query reports %d\n", per_cu);
        grid = cus;
        for (int i = 0; i < 32; ++i) invf[i] = powf(10000.0f, -(float)i / 32.0f);
    }
    if (grid < 0) return;
    (void)hipMemsetAsync((char*)d_ws + WS_CTL, 0, CTL_ZERO_BYTES, stream);
    Args a{};
    a.x = (const float*)d_in[0]; a.c = (const float*)d_in[1]; a.pos = (const int*)d_in[2]; a.w_ada = (const float*)d_in[3]; a.b_ada = (const float*)d_in[4]; a.norm_mix_g = (const float*)d_in[5];
    a.w_in = (const float*)d_in[6]; a.conv_w = (const float*)d_in[7]; a.q_lat_g = (const float*)d_in[8]; a.w_uq = (const float*)d_in[9]; a.kv_lat_g = (const float*)d_in[10]; a.w_ukv = (const float*)d_in[11];
    a.q_head_g = (const float*)d_in[12]; a.k_head_g = (const float*)d_in[13]; a.conv_out_g = (const float*)d_in[14]; a.mla_out_g = (const float*)d_in[15]; a.w_out = (const float*)d_in[16];
    a.norm_ffn_g = (const float*)d_in[17]; a.router_w = (const float*)d_in[18]; a.router_b = (const float*)d_in[19]; a.w_gu = (const float*)d_in[20]; a.b_gu = (const float*)d_in[21];
    a.w_down = (const float*)d_in[22]; a.b_down = (const float*)d_in[23];
    a.out = (float*)d_out; a.ws = (unsigned char*)d_ws;
    for (int i = 0; i < 32; ++i) a.invf[i] = invf[i];
#if MK_ONE_LAUNCH
    a.ph_lo = 0; a.ph_hi = NPH;
    hipLaunchKernelGGL(fwd, dim3(grid), dim3(512), LDS_BYTES, stream, a);
#else
    for (int p = 0; p < NPH; ++p) { a.ph_lo = p; a.ph_hi = p + 1; hipLaunchKernelGGL(fwd, dim3(grid), dim3(512), LDS_BYTES, stream, a); }
#endif
}
```

```cpp
#include <hip/hip_runtime.h>
#include <cstdio>
#include <cstdint>
#include <cmath>

#ifndef MK_ONE_LAUNCH
#define MK_ONE_LAUNCH 1
#endif

#ifndef PROBE_CVT
#define PROBE_CVT 0
#endif
#ifndef REP_P0
#define REP_P0 1
#endif
#ifndef REP_PROJ
#define REP_PROJ 1
#endif
#ifndef REP_ATT
#define REP_ATT 1
#endif
#ifndef REP_MOE1
#define REP_MOE1 1
#endif
#ifndef REP_MOE2
#define REP_MOE2 1
#endif
#ifndef REP_THIN
#define REP_THIN 1
#endif
#ifndef REP_P8
#define REP_P8 1
#endif
#ifndef REP_P9
#define REP_P9 1
#endif
#ifndef REP_P1
#define REP_P1 REP_THIN
#endif
#ifndef REP_P5
#define REP_P5 REP_THIN
#endif
#ifndef REP_P12
#define REP_P12 REP_THIN
#endif
#ifndef REP_P2
#define REP_P2 REP_PROJ
#endif
#ifndef REP_P4
#define REP_P4 REP_PROJ
#endif
#ifndef REP_P7
#define REP_P7 REP_PROJ
#endif

#define GAS __attribute__((address_space(1)))
#define LAS __attribute__((address_space(3)))
typedef unsigned short bf16;
typedef short bf16x8 __attribute__((ext_vector_type(8)));
typedef short s16x4 __attribute__((ext_vector_type(4)));
typedef float f32x2 __attribute__((ext_vector_type(2)));
typedef float f32x4 __attribute__((ext_vector_type(4)));
typedef float f32x16 __attribute__((ext_vector_type(16)));
typedef unsigned u32x2 __attribute__((ext_vector_type(2)));
typedef unsigned u32x4 __attribute__((ext_vector_type(4)));
typedef GAS unsigned gu32;

constexpr int NB = 2, SEQ = 16384, T = NB * SEQ, DM = 2048;
constexpr int CONVD = 1024, QLORA = 768, KVLORA = 512, ROPE = 64, NOPE = 128, DQK = 192, DV = 128, NH = 8;
constexpr int DIN = 4416, DINP = 4608;
constexpr int C_B = 0, C_C = 1024, C_U = 2048, C_QL = 3072, C_KVL = 3840, C_KPE = 4352;
constexpr int NE = 32, TOPK = 4, FF = 2048;
constexpr int NBLK_MAX = T * TOPK / 256 + NE;
constexpr int PROWS = NBLK_MAX * 256;
constexpr float EPS = 1e-6f;
constexpr int KATT = 96;
constexpr float WSCALE = 64.0f, ASCALE = 2.0f, HSCALE = 2.0f, YSCALE = 32.0f, MSCALE = 4.0f;
constexpr int NPH = 13;

constexpr size_t MiB = 1u << 20;
constexpr size_t WS_CTL = 0, CTL_ZERO_BYTES = 128 * 1024;
constexpr size_t WS_MOD = 1 * MiB;
constexpr size_t WS_BIAS2 = WS_MOD + 128 * 1024;
constexpr size_t WS_BLK = WS_MOD + 256 * 1024;
constexpr size_t WS_ROPE = 2 * MiB;
constexpr size_t WS_RSTD2 = 10 * MiB;
constexpr size_t WS_WR = 3572 * MiB;
constexpr size_t WS_AS2 = 3573 * MiB;
constexpr size_t WS_X1P = 3574 * MiB;
constexpr size_t WS_H2 = 3580 * MiB;
constexpr size_t WS_LATP = 3568 * MiB;
constexpr size_t WS_TOPE = 11 * MiB;
constexpr size_t WS_GATE = 12 * MiB;
constexpr size_t WS_RANK = 13 * MiB;
constexpr size_t WS_ROWGATE = 14 * MiB;
constexpr size_t WS_DEST = 15 * MiB;
constexpr size_t WS_TOKMAP = 15 * MiB + 512 * 1024;
constexpr size_t WS_WIN = 16 * MiB;
constexpr size_t WS_WUQ = 34 * MiB;
constexpr size_t WS_WUKV = 37 * MiB;
constexpr size_t WS_WOUT = 39 * MiB;
constexpr size_t WS_WGU = 48 * MiB;
constexpr size_t WS_WD = 560 * MiB;
constexpr size_t WS_H = 816 * MiB;
constexpr size_t WS_PROJ = 944 * MiB;
constexpr size_t WS_QRAW = 1232 * MiB;
constexpr size_t WS_KVRAW = 1328 * MiB;
constexpr size_t WS_K = 1456 * MiB;
constexpr size_t WS_MIXED = 1552 * MiB;
constexpr size_t WS_X1 = 1680 * MiB;
constexpr size_t WS_HS = 1936 * MiB;
constexpr size_t WS_ACT = 2480 * MiB;
constexpr size_t WS_YBUF = 3024 * MiB;
constexpr size_t WS_END = 3644 * MiB;
constexpr int CW_BAR = 4096;
constexpr int CW_CNT = 16384;

constexpr int RING_BYTES = 131072;
constexpr int LDS_BYTES = 163840;
constexpr int LDSCTL_OFF = LDS_BYTES - 1024, MISC_OFF = LDSCTL_OFF + 320;

__device__ __forceinline__ float bf2f(unsigned short u) { return __builtin_bit_cast(float, (unsigned)u << 16); }
__device__ __forceinline__ unsigned cvtpk(float lo, float hi) { unsigned r; asm volatile("v_cvt_pk_bf16_f32 %0, %1, %2" : "=v"(r) : "v"(lo), "v"(hi)); return r; }
__device__ __forceinline__ float wave_sum(float v) {
#pragma unroll
    for (int o = 1; o < 64; o <<= 1) v += __shfl_xor(v, o);
    return v;
}
__device__ __forceinline__ void unpack8(const bf16x8 v, float* f) {
#pragma unroll
    for (int j = 0; j < 8; ++j) f[j] = bf2f((unsigned short)v[j]);
}
__device__ __forceinline__ bf16x8 pack8f(const float* f) {
    u32x4 w = {cvtpk(f[0], f[1]), cvtpk(f[2], f[3]), cvtpk(f[4], f[5]), cvtpk(f[6], f[7])};
    return __builtin_bit_cast(bf16x8, w);
}
__device__ __forceinline__ unsigned ld_agent(const unsigned* p) { return __hip_atomic_load((unsigned*)p, __ATOMIC_RELAXED, __HIP_MEMORY_SCOPE_AGENT); }

#define XB_TMO      128
#define XB_XCNT(j)  (256  + 64 * (j))
#define XB_XSUB(j)  (1280 + 64 * (j))
#define XB_XGEN(j)  (2304 + 64 * (j))
#define XB_TOP      3328
#define XB_TOPGEN   3392
#define XCD_BAR_WORDS 3456
#define XB_SPIN_CAP (1u << 20)

__device__ __forceinline__ unsigned xb_ld(unsigned* p)              { return __hip_atomic_load(p, __ATOMIC_RELAXED, __HIP_MEMORY_SCOPE_AGENT); }
__device__ __forceinline__ unsigned xb_add(unsigned* p, unsigned v) { return __hip_atomic_fetch_add(p, v, __ATOMIC_RELAXED, __HIP_MEMORY_SCOPE_AGENT); }
__device__ __forceinline__ unsigned xb_xcc_id() { return (unsigned)__builtin_amdgcn_s_getreg((3 << 11) | 20) & 0xFu; }
#define XB_SPIN(cond, bar) do { unsigned _sp = 0; while (cond) { __builtin_amdgcn_s_sleep(1); \
    if ((++_sp & 255u) == 0u) { if (xb_ld(&(bar)[XB_TMO])) break; if (_sp > XB_SPIN_CAP) { atomicAdd(&(bar)[XB_TMO], 1u); break; } } } } while (0)

__device__ __forceinline__ int lane_id() { int l; asm volatile("v_mbcnt_lo_u32_b32 %0, -1, 0\n\tv_mbcnt_hi_u32_b32 %0, -1, %0" : "=v"(l)); return l; }
#define TID_NOW(wave) ((wave) * 64 + lane_id())
struct XcdBarrier { unsigned* bar; unsigned x; volatile LAS unsigned* st; };

__device__ __forceinline__ XcdBarrier xcd_barrier_post(unsigned* bar, volatile LAS unsigned* st, int wave) {
    XcdBarrier b; b.bar = bar; b.x = xb_xcc_id(); b.st = st;
    if (TID_NOW(wave) == 0) (void)xb_add(&bar[XB_XCNT(b.x)], 1u);
    return b;
}
__device__ __forceinline__ void xcd_barrier_complete(unsigned* bar, unsigned x, unsigned& nloc, unsigned& nx) {
    const unsigned G = gridDim.x * gridDim.y * gridDim.z;
    unsigned sum, cnt, mine, sp = 0u;
    for (;;) {
        sum = 0u; cnt = 0u; mine = 0u;
#pragma unroll
        for (unsigned j = 0; j < 16; ++j) { const unsigned c = xb_ld(&bar[XB_XCNT(j)]); sum += c; cnt += (c > 0u) ? 1u : 0u; mine = (j == x) ? c : mine; }
        if (sum == G) break;
        __builtin_amdgcn_s_sleep(1);
        if ((++sp & 255u) == 0u) { if (xb_ld(&bar[XB_TMO])) break; if (sp > XB_SPIN_CAP) { atomicAdd(&bar[XB_TMO], 1u); break; } }
    }
    nloc = mine > 0u ? mine : 1u; nx = cnt > 0u ? cnt : 1u;
}
__device__ __forceinline__ void xcd_barrier(const XcdBarrier& b, int wave) {
    asm volatile("s_waitcnt vmcnt(0)" ::: "memory");
    __syncthreads();
    if (TID_NOW(wave) == 0) {
        unsigned* bar = b.bar;
        __builtin_amdgcn_s_waitcnt(0);
        unsigned nloc = b.st[0], nx = b.st[1];
        if (nloc == 0u) { xcd_barrier_complete(bar, b.x, nloc, nx); b.st[0] = nloc; b.st[1] = nx; }
        const unsigned old = xb_add(&bar[XB_XSUB(b.x)], 1u);
        const unsigned gen = old / nloc;
        if (old + 1u == (gen + 1u) * nloc) {
            __builtin_amdgcn_fence(__ATOMIC_RELEASE, "agent");
            asm volatile("s_waitcnt vmcnt(0)" ::: "memory");
            const unsigned og = xb_add(&bar[XB_TOP], 1u);
            const unsigned tg = og / nx;
            if (og + 1u == (tg + 1u) * nx) xb_add(&bar[XB_TOPGEN], 1u);
            else XB_SPIN(xb_ld(&bar[XB_TOPGEN]) == tg, bar);
            __builtin_amdgcn_fence(__ATOMIC_ACQUIRE, "agent");
            xb_add(&bar[XB_XGEN(b.x)], 1u);
            asm volatile("s_waitcnt vmcnt(0)" ::: "memory");
        } else {
            XB_SPIN(xb_ld(&bar[XB_XGEN(b.x)]) == gen, bar);
            __builtin_amdgcn_fence(__ATOMIC_ACQUIRE, "agent");
            asm volatile("s_waitcnt vmcnt(0)" ::: "memory");
        }
    }
    __syncthreads();
}

namespace pg8 {
constexpr int BM = 256, BK = 64, HALF = 128, HTB = HALF * BK * 2, NXCD = 8, WGM = 8;
__host__ __device__ __forceinline__ int lds_byte(int r, int c) { const int st = (r >> 4) * 2 + (c >> 5), rr = r & 15, cc = c & 31, ob = rr * 64 + cc * 2; return st * 1024 + (ob ^ (((ob >> 9) & 1) << 5)); }
__host__ __device__ __forceinline__ void stage_rc(int b, int& R, int& C) { const int st = b / 1024, sb = b % 1024, swz = sb ^ (((sb >> 9) & 1) << 5); R = (st >> 1) * 16 + swz / 64; C = (st & 1) * 32 + (swz % 64) / 2; }
__host__ __device__ __forceinline__ int perm32(int rho) { const int n = rho >> 4, i = rho & 15; return 8 * (i >> 2) + 4 * n + (i & 3); }

struct Unit { int pm, pn, e; };
struct Gemm { const void* A; const void* Bt; int ldaB; int KB; size_t estride; const unsigned short* rowmap; };

struct TileOrder {
    int nM, nN, nwg, G, c; const int* blk_e; int i0, i1;
    __device__ void init(int nM_, int nN_, int G_, int c_, const int* blk_e_, int i0_ = 0, int i1_ = 0x7fffffff) { nM = nM_; nN = nN_; nwg = nM * nN; G = G_; c = c_; blk_e = blk_e_; i0 = i0_; i1 = i1_; }
    __device__ bool next(int ii, Unit& u) const {
        const int i = ii + i0; if (i >= i1) return false;
        const long L = (long)i * G + c; if (L >= nwg) return false;
        int wgid = (int)L; { const int q = nwg / NXCD, r = nwg % NXCD, xcd = wgid % NXCD, off = wgid / NXCD; wgid = (xcd < r ? xcd * (q + 1) : r * (q + 1) + (xcd - r) * q) + off; }
        const int nig = WGM * nN, gid = wgid / nig, fm = gid * WGM, gsz = (nM - fm) < WGM ? (nM - fm) : WGM;
        u.pm = fm + ((wgid % nig) % gsz); u.pn = (wgid % nig) / gsz;
        u.e = blk_e ? __builtin_amdgcn_readfirstlane((int)ld_agent((const unsigned*)(blk_e + u.pm))) : 0;
        return true;
    }
};

typedef int v8i __attribute__((ext_vector_type(8)));
union Frag { v8i v; bf16x8 q[2]; };
template <bool FP8, bool GATHER, class Epi, class Sched>
__device__ __forceinline__ void gemm_phase(LAS unsigned char* lds, const Gemm g, const Sched& S, const Epi& E, int wave) {
    const int tid = TID_NOW(wave), wid = wave, lane = tid & 63, wr = wid >> 2, wc = wid & 3, fr = lane & 15, fq = lane >> 4;
    const int KB = g.KB, nt = KB / (BK * 2), ldaB = g.ldaB;
    unsigned voffA[2], voffB[2];
#pragma unroll
    for (int i = 0; i < 2; ++i) { int R, C; stage_rc(tid * 16 + i * 8192, R, C); const int Rb = (R & ~31) + perm32(R & 31);
        voffA[i] = (unsigned)(R * ldaB + C * 2); voffB[i] = (unsigned)(Rb * KB + C * 2); }
    const size_t kstep = (size_t)(BK * 2);
    const size_t hstepA = (size_t)HALF * ldaB, hstepB = (size_t)HALF * KB;
    const size_t tstepA = 2 * hstepA, tstepB = 2 * hstepB;
    const unsigned ldsw = (unsigned)wid * 1024u;
    const int aoff = lds_byte(wr * 64 + fr, fq * 8), boff = lds_byte(wc * 32 + fr, fq * 8);
    LAS unsigned short* lt = (LAS unsigned short*)(lds + 8 * HTB);
    unsigned gA0[2] = {0u, 0u}, gA1[2] = {0u, 0u}; int rA[2] = {0, 0}; unsigned cA2[2] = {0u, 0u};
    if constexpr (GATHER) {
        Unit uu;
        for (int i = 0; i < 34 && S.next(i, uu); ++i) { if (tid < 256) lt[i * 256 + tid] = g.rowmap[(size_t)uu.pm * 256 + tid]; }
        __syncthreads();
#pragma unroll
        for (int i = 0; i < 2; ++i) { int R, C; stage_rc(tid * 16 + i * 8192, R, C); rA[i] = R; cA2[i] = (unsigned)(C * 2); }
    }
#define PG8_GOFF(u, hh, i) ((unsigned)lt[(u) * 256 + (hh) * 128 + rA[i]] * (unsigned)ldaB + cA2[i])
#define PG8_SA(b, h) (((b) * 2 + (h)) * HTB)
#define PG8_SB(b, h) ((4 + (b) * 2 + (h)) * HTB)
#define PG8_STAGE(bufoff, gbase, voff) do { _Pragma("unroll") for (int _i = 0; _i < 2; ++_i) \
        __builtin_amdgcn_global_load_lds((const unsigned*)((const char*)(gbase) + (voff)[_i]), (LAS unsigned*)(lds + (bufoff) + ldsw + _i * 8192), 16, 0, 0); } while (0)
#define PG8_LDA(dst, b, h) do { _Pragma("unroll") for (int m = 0; m < 4; ++m) _Pragma("unroll") for (int k = 0; k < 2; ++k) dst[m].q[k] = *(const LAS bf16x8*)(lds + PG8_SA(b, h) + aoff + m * 2048 + k * 1024); } while (0)
#define PG8_LDB(dst, b, h) do { _Pragma("unroll") for (int n = 0; n < 2; ++n) _Pragma("unroll") for (int k = 0; k < 2; ++k) dst[n].q[k] = *(const LAS bf16x8*)(lds + PG8_SB(b, h) + boff + n * 2048 + k * 1024); } while (0)
#define PG8_MMA(ai, bj, At, Bt) do { __builtin_amdgcn_s_setprio(1); _Pragma("unroll") for (int m = 0; m < 4; ++m) _Pragma("unroll") for (int n = 0; n < 2; ++n) { \
        if constexpr (FP8) asm volatile("v_mfma_f32_16x16x128_f8f6f4 %0, %1, %2, %0" : "+v"(acc[ai][bj][m][n]) : "v"(Bt[n].v), "v"(At[m].v));   \
        else { _Pragma("unroll") for (int k = 0; k < 2; ++k) acc[ai][bj][m][n] = __builtin_amdgcn_mfma_f32_16x16x32_bf16(Bt[n].q[k], At[m].q[k], acc[ai][bj][m][n], 0, 0, 0); } } \
        __builtin_amdgcn_s_setprio(0); } while (0)
#define PG8_WAIT_V(n) asm volatile("s_waitcnt vmcnt(" #n ")" ::: "memory")
#define PG8_WAIT_L(n) asm volatile("s_waitcnt lgkmcnt(" #n ")" ::: "memory")
#define PG8_BAR __builtin_amdgcn_s_barrier()
#define PG8_SCHED __builtin_amdgcn_sched_barrier(0)
    Unit cur, nxt; int ui = 0;
    if (!S.next(0, cur)) return;
    f32x4 acc[2][2][4][2];
#pragma unroll
    for (int a = 0; a < 2; ++a)
#pragma unroll
        for (int b = 0; b < 2; ++b)
#pragma unroll
            for (int m = 0; m < 4; ++m)
#pragma unroll
                for (int n = 0; n < 2; ++n) acc[a][b][m][n] = (f32x4){0.f, 0.f, 0.f, 0.f};
    Frag At[4], B0[2], B1[2];
    const char* cA = GATHER ? (const char*)g.A : (const char*)g.A + (size_t)cur.pm * tstepA; const char* cB = (const char*)g.Bt + (size_t)cur.e * g.estride + (size_t)cur.pn * tstepB;
    if constexpr (GATHER) {
#pragma unroll
        for (int i = 0; i < 2; ++i) { gA0[i] = PG8_GOFF(0, 0, i); gA1[i] = PG8_GOFF(0, 1, i); }
        cA = (const char*)g.A;
        PG8_STAGE(PG8_SB(0, 0), cB, voffB); PG8_STAGE(PG8_SB(0, 1), cB + hstepB, voffB); PG8_STAGE(PG8_SA(0, 0), cA, gA0); PG8_STAGE(PG8_SA(0, 1), cA, gA1);
        if (wr == 1) PG8_BAR;
        PG8_WAIT_V(2); PG8_BAR;
        PG8_STAGE(PG8_SB(1, 0), cB + kstep, voffB); PG8_STAGE(PG8_SA(1, 0), cA + kstep, gA0); PG8_STAGE(PG8_SB(1, 1), cB + hstepB + kstep, voffB);
        PG8_WAIT_V(6); PG8_BAR;
    } else {
    PG8_STAGE(PG8_SB(0, 0), cB, voffB); PG8_STAGE(PG8_SB(0, 1), cB + hstepB, voffB); PG8_STAGE(PG8_SA(0, 0), cA, voffA); PG8_STAGE(PG8_SA(0, 1), cA + hstepA, voffA);
    if (wr == 1) PG8_BAR;
    PG8_WAIT_V(2); PG8_BAR;
    PG8_STAGE(PG8_SB(1, 0), cB + kstep, voffB); PG8_STAGE(PG8_SA(1, 0), cA + kstep, voffA); PG8_STAGE(PG8_SB(1, 1), cB + hstepB + kstep, voffB);
    PG8_WAIT_V(6); PG8_BAR;
    }
    for (;;) {
        const bool has_next = S.next(ui + 1, nxt);
        const char* nA = (has_next && !GATHER) ? (const char*)g.A + (size_t)nxt.pm * tstepA : cA;
        const char* nB = has_next ? (const char*)g.Bt + (size_t)nxt.e * g.estride + (size_t)nxt.pn * tstepB : cB;
        for (int t = 0; t < nt; t += 2) {
            const bool last = (t == nt - 2);
            const char* a1 = cA + (size_t)(t + 1) * kstep;
            const char* a2 = last ? nA : cA + (size_t)(t + 2) * kstep; const char* b2 = last ? nB : cB + (size_t)(t + 2) * kstep;
            const char* a3 = a2 + kstep; const char* b3 = b2 + kstep;
            unsigned s0[2] = {0u, 0u}, s1[2] = {0u, 0u};
            if constexpr (GATHER) {
#pragma unroll
                for (int i = 0; i < 2; ++i) { s0[i] = (last && has_next) ? PG8_GOFF(ui + 1, 0, i) : gA0[i]; s1[i] = (last && has_next) ? PG8_GOFF(ui + 1, 1, i) : gA1[i]; } }
            PG8_LDB(B0, 0, 0); PG8_LDB(B1, 0, 1); PG8_SCHED; PG8_LDA(At, 0, 0);
            if constexpr (GATHER) PG8_STAGE(PG8_SA(1, 1), a1, gA1); else PG8_STAGE(PG8_SA(1, 1), a1 + hstepA, voffA);
            PG8_WAIT_V(8); PG8_WAIT_L(0); PG8_BAR; PG8_MMA(0, 0, At, B0); PG8_MMA(0, 1, At, B1); PG8_BAR; PG8_SCHED;
            PG8_LDA(At, 0, 1); PG8_STAGE(PG8_SB(0, 0), b2, voffB); PG8_STAGE(PG8_SB(0, 1), b2 + hstepB, voffB);
            if constexpr (GATHER) PG8_STAGE(PG8_SA(0, 0), a2, s0); else PG8_STAGE(PG8_SA(0, 0), a2, voffA);
            PG8_WAIT_V(8); PG8_WAIT_L(0); PG8_BAR; PG8_MMA(1, 0, At, B0); PG8_MMA(1, 1, At, B1); PG8_BAR; PG8_SCHED;
            PG8_LDB(B0, 1, 0); PG8_LDB(B1, 1, 1); PG8_SCHED; PG8_LDA(At, 1, 0);
            if constexpr (GATHER) PG8_STAGE(PG8_SA(0, 1), a2, s1); else PG8_STAGE(PG8_SA(0, 1), a2 + hstepA, voffA);
            PG8_WAIT_V(8); PG8_WAIT_L(0); PG8_BAR; PG8_MMA(0, 0, At, B0); PG8_MMA(0, 1, At, B1); PG8_BAR; PG8_SCHED;
            PG8_LDA(At, 1, 1); PG8_STAGE(PG8_SB(1, 0), b3, voffB); PG8_STAGE(PG8_SB(1, 1), b3 + hstepB, voffB);
            if constexpr (GATHER) PG8_STAGE(PG8_SA(1, 0), a3, s0); else PG8_STAGE(PG8_SA(1, 0), a3, voffA);
            PG8_WAIT_V(8); PG8_WAIT_L(0); PG8_BAR; PG8_MMA(1, 0, At, B0); PG8_MMA(1, 1, At, B1); PG8_BAR; PG8_SCHED;
        }
        if (wr == 0) PG8_BAR;
        if constexpr (FP8) asm volatile("s_nop 15\n\ts_nop 15" ::: "memory");
        E(acc, cur, wr, wc, fr, fq);
        if (!has_next) break;
#pragma unroll
        for (int a = 0; a < 2; ++a)
#pragma unroll
            for (int b = 0; b < 2; ++b)
#pragma unroll
                for (int m = 0; m < 4; ++m)
#pragma unroll
                    for (int n = 0; n < 2; ++n) acc[a][b][m][n] = (f32x4){0.f, 0.f, 0.f, 0.f};
        cur = nxt; cA = nA; cB = nB; ++ui;
        if constexpr (GATHER) {
#pragma unroll
            for (int i = 0; i < 2; ++i) { gA0[i] = PG8_GOFF(ui, 0, i); gA1[i] = PG8_GOFF(ui, 1, i); } }
        if (wr == 1) PG8_BAR;
    }
    PG8_WAIT_V(0);
    PG8_BAR;
#undef PG8_GOFF
#undef PG8_SA
#undef PG8_SB
#undef PG8_STAGE
#undef PG8_LDA
#undef PG8_LDB
#undef PG8_MMA
#undef PG8_WAIT_V
#undef PG8_WAIT_L
#undef PG8_BAR
#undef PG8_SCHED
}

typedef const f32x4 (&AccRef)[2][2][4][2];
constexpr int NPART = 20;
struct EpiBf16 {
    bf16* O; int ldc; float* parts_out; const float* parts_in; int pofs; int np; float invn;
    __device__ __forceinline__ void operator()(AccRef acc, const Unit& u, int wr, int wc, int fr, int fq) const {
        const int row0 = u.pm * BM + wr * 64 + fr, col0 = u.pn * BM + wc * 32 + 8 * fq;
        if (parts_out && u.pn >= 12 && u.pn < 17) {
#pragma unroll
            for (int ai = 0; ai < 2; ++ai)
#pragma unroll
                for (int m = 0; m < 4; ++m) { float ss = 0.f;
#pragma unroll
                    for (int bj = 0; bj < 2; ++bj)
#pragma unroll
                        for (int n = 0; n < 2; ++n) { const f32x4 v = acc[ai][bj][m][n]; ss += (v[0] * v[0] + v[1] * v[1]) + (v[2] * v[2] + v[3] * v[3]); }
                    ss += __shfl_xor(ss, 16); ss += __shfl_xor(ss, 32);
                    if (fq == 0) parts_out[(size_t)(row0 + ai * HALF + m * 16) * NPART + (u.pn - 12) * 4 + wc] = ss; }
        }
        float scs[2][4];
#pragma unroll
        for (int ai = 0; ai < 2; ++ai)
#pragma unroll
            for (int m = 0; m < 4; ++m) { scs[ai][m] = 1.f;
                if (parts_in) { const float* pp = parts_in + (size_t)(row0 + ai * HALF + m * 16) * NPART + pofs; float ss = 0.f;
                    for (int i = 0; i < np; i += 4) { const f32x4 v = *(const f32x4*)(pp + i); ss += (v[0] + v[1]) + (v[2] + v[3]); }
                    scs[ai][m] = 1.0f / sqrtf(ss * invn + EPS); } }
#pragma unroll
        for (int ai = 0; ai < 2; ++ai)
#pragma unroll
            for (int m = 0; m < 4; ++m) { const int row = row0 + ai * HALF + m * 16; const float sc = scs[ai][m];
                bf16* rowp = O + (size_t)row * ldc + col0;
#pragma unroll
                for (int bj = 0; bj < 2; ++bj) { const f32x4 v0 = acc[ai][bj][m][0] * sc, v1 = acc[ai][bj][m][1] * sc;
                    u32x4 w; w.x = cvtpk(v0[0], v0[1]); w.y = cvtpk(v0[2], v0[3]); w.z = cvtpk(v1[0], v1[1]); w.w = cvtpk(v1[2], v1[3]);
                    *(u32x4*)(rowp + bj * HALF) = w; } }
    }
};
struct EpiResF32 {
    const float* X; bf16* O; const float* gm; float* parts; float sc;
    __device__ __forceinline__ void operator()(AccRef acc, const Unit& u, int wr, int wc, int fr, int fq) const {
        const int row0 = u.pm * BM + wr * 64 + fr, col0 = u.pn * BM + wc * 32 + 8 * fq;
        const float* g = gm + (size_t)((u.pm * BM) / SEQ) * (6 * DM) + col0;
        f32x4 gv[2][2];
#pragma unroll
        for (int bj = 0; bj < 2; ++bj)
#pragma unroll
            for (int n = 0; n < 2; ++n) gv[bj][n] = *(const f32x4*)(g + bj * HALF + 4 * n) * sc;
        float ssv[2][4];
#pragma unroll
        for (int ai = 0; ai < 2; ++ai) {
            f32x4 xv[4][2][2];
#pragma unroll
            for (int m = 0; m < 4; ++m) { const size_t off = (size_t)(row0 + ai * HALF + m * 16) * DM + col0;
#pragma unroll
                for (int bj = 0; bj < 2; ++bj) { xv[m][bj][0] = __builtin_nontemporal_load((const f32x4*)(X + off + bj * HALF)); xv[m][bj][1] = __builtin_nontemporal_load((const f32x4*)(X + off + bj * HALF + 4)); } }
#pragma unroll
            for (int m = 0; m < 4; ++m) { const size_t off = (size_t)(row0 + ai * HALF + m * 16) * DM + col0; float ss = 0.f;
#pragma unroll
                for (int bj = 0; bj < 2; ++bj) {
                    const f32x4 v0 = xv[m][bj][0] + gv[bj][0] * acc[ai][bj][m][0], v1 = xv[m][bj][1] + gv[bj][1] * acc[ai][bj][m][1];
                    ss += ((v0[0] * v0[0] + v0[1] * v0[1]) + (v0[2] * v0[2] + v0[3] * v0[3])) + ((v1[0] * v1[0] + v1[1] * v1[1]) + (v1[2] * v1[2] + v1[3] * v1[3]));
                    u32x4 w; w.x = cvtpk(v0[0], v0[1]); w.y = cvtpk(v0[2], v0[3]); w.z = cvtpk(v1[0], v1[1]); w.w = cvtpk(v1[2], v1[3]);
                    *(u32x4*)(O + off + bj * HALF) = w; }
                ss += __shfl_xor(ss, 16); ss += __shfl_xor(ss, 32); ssv[ai][m] = ss; }
        }
        if (fq == 0) {
#pragma unroll
            for (int ai = 0; ai < 2; ++ai)
#pragma unroll
                for (int m = 0; m < 4; ++m) parts[(size_t)(row0 + ai * HALF + m * 16) * 32 + u.pn * 4 + wc] = ssv[ai][m]; }
    }
};
__device__ __forceinline__ unsigned pk_fp8x4(float a, float b, float c, float d) { int w = __builtin_amdgcn_cvt_pk_fp8_f32(a, b, 0, false); w = __builtin_amdgcn_cvt_pk_fp8_f32(c, d, w, true); return (unsigned)w; }
struct EpiSwiglu {
    unsigned char* O; const float* bgu; float ascale;
    __device__ __forceinline__ void operator()(AccRef acc, const Unit& u, int wr, int wc, int fr, int fq) const {
        const int row0 = u.pm * BM + wr * 64 + fr, col0 = u.pn * HALF + wc * 32 + 8 * fq;
        const float* bp = bgu + (size_t)u.e * (2 * FF) + col0;
        f32x2 bg[4], bu[4];
#pragma unroll
        for (int q = 0; q < 4; ++q) { bg[q] = *(const f32x2*)(bp + 2 * q); bu[q] = *(const f32x2*)(bp + FF + 2 * q); }
        const f32x2 as2 = {ascale, ascale}, c2 = {-1.702f * 1.4426950408889634f, -1.702f * 1.4426950408889634f}, one2 = {1.0f, 1.0f}, sc2 = {ASCALE, ASCALE};
#pragma unroll
        for (int ai = 0; ai < 2; ++ai)
#pragma unroll
            for (int m = 0; m < 4; ++m) { f32x2 r[4];
#pragma unroll
                for (int q = 0; q < 4; ++q) { const int n = q >> 1, i = (q & 1) * 2;
                    f32x2 gt = (f32x2){acc[ai][0][m][n][i], acc[ai][0][m][n][i + 1]} * as2 + bg[q];
                    f32x2 up = (f32x2){acc[ai][1][m][n][i], acc[ai][1][m][n][i + 1]} * as2 + bu[q];
                    gt.x = fminf(gt.x, 7.0f); gt.y = fminf(gt.y, 7.0f);
                    up.x = __builtin_amdgcn_fmed3f(up.x, -7.0f, 7.0f); up.y = __builtin_amdgcn_fmed3f(up.y, -7.0f, 7.0f);
                    const f32x2 ea = gt * c2; f32x2 e; e.x = __builtin_amdgcn_exp2f(ea.x); e.y = __builtin_amdgcn_exp2f(ea.y);
                    const f32x2 den = e + one2; f32x2 sg; sg.x = __builtin_amdgcn_rcpf(den.x); sg.y = __builtin_amdgcn_rcpf(den.y);
                    r[q] = ((up * sc2 + sc2) * gt) * sg; }
                u32x2 w; w.x = pk_fp8x4(r[0].x, r[0].y, r[1].x, r[1].y); w.y = pk_fp8x4(r[2].x, r[2].y, r[3].x, r[3].y);
                *(u32x2*)(O + (size_t)(row0 + ai * HALF + m * 16) * FF + col0) = w; }
    }
};
struct EpiDown {
    unsigned char* O; const float* bd; const float* rowgate; float ascale;
    __device__ __forceinline__ void operator()(AccRef acc, const Unit& u, int wr, int wc, int fr, int fq) const {
        const int row0 = u.pm * BM + wr * 64 + fr, col0 = u.pn * BM + wc * 32 + 8 * fq;
        const float* bp = bd + (size_t)u.e * DM + col0;
        f32x4 bv[2][2];
#pragma unroll
        for (int bj = 0; bj < 2; ++bj)
#pragma unroll
            for (int n = 0; n < 2; ++n) bv[bj][n] = *(const f32x4*)(bp + bj * HALF + 4 * n);
        float gts[2][4];
#pragma unroll
        for (int ai = 0; ai < 2; ++ai)
#pragma unroll
            for (int m = 0; m < 4; ++m) gts[ai][m] = rowgate[row0 + ai * HALF + m * 16];
#pragma unroll
        for (int ai = 0; ai < 2; ++ai)
#pragma unroll
            for (int m = 0; m < 4; ++m) { const int row = row0 + ai * HALF + m * 16; const float gt = gts[ai][m] * YSCALE;
                unsigned char* rowp = O + (size_t)row * DM + col0;
#pragma unroll
                for (int bj = 0; bj < 2; ++bj) { const f32x4 v0 = (acc[ai][bj][m][0] * ascale + bv[bj][0]) * gt, v1 = (acc[ai][bj][m][1] * ascale + bv[bj][1]) * gt;
                    u32x2 w; w.x = pk_fp8x4(v0[0], v0[1], v0[2], v0[3]); w.y = pk_fp8x4(v1[0], v1[1], v1[2], v1[3]);
                    *(u32x2*)(rowp + bj * HALF) = w; } }
    }
};
}

namespace att {
constexpr int KVBLK = 64;
constexpr int SHM_V = 16384, SHM_KN = 16384, SHM_KR = 8192;
constexpr int OFF_V = 0, OFF_KN = 2 * SHM_V, OFF_KR = OFF_KN + 2 * SHM_KN, OFF_WS = OFF_KR + 2 * SHM_KR;
constexpr float QSCALE = 0.07216878364870322f * 1.4426950408889634f;
#define KSWZ(row, colB) ((row) * 256 + ((colB) ^ (((row) & 15) << 4)))
#define SBAR() __builtin_amdgcn_sched_barrier(0)
__device__ __forceinline__ int v_st(int k, int c) { const int kk = (k & ~0xC) | ((k & 4) << 1) | ((k & 8) >> 1); return ((kk >> 3) * 4 + (c >> 5)) * 512 + ((kk & 7) * 32 + (c & 31)) * 2; }
__device__ __forceinline__ int v_rd_base(int lane) { return ((lane & 3) << 3) | (((lane >> 2) & 3) << 6) | (((lane >> 4) & 1) << 5) | (((lane >> 5) & 1) << 8); }
constexpr int v_rd_off(int d0, int ks, int half) { return d0 * 512 + ks * 4096 + half * 2048; }
__device__ __forceinline__ int crow(int r, int hi) { return (r & 3) + 8 * (r >> 2) + 4 * hi; }

__device__ __forceinline__ void mask_tile(f32x16& p0, f32x16& p1, int dq) {
    const float NEG = -__builtin_inff();
#pragma unroll
    for (int r = 0; r < 16; ++r) {
        const int c = (r & 3) + 8 * (r >> 2);
        if (dq - c < 0) p0[r] = NEG;
        if (dq - c - 32 < 0) p1[r] = NEG;
    }
}
template <int KB>
__device__ __forceinline__ void qkt(f32x16& p0, f32x16& p1, const LAS char* lds, int r32, int hi, const bf16x8* qr, const f32x16& negm) {
    p0 = negm; p1 = negm;
    const LAS char* kb[8];
#pragma unroll
    for (int dd = 0; dd < 8; ++dd) kb[dd] = lds + OFF_KN + KB * SHM_KN + KSWZ(r32, (dd * 16 + hi * 8) * 2);
    const LAS char* kr = lds + OFF_KR + KB * SHM_KR + r32 * 128; const int sw = (r32 >> 1) & 7;
    bf16x8 f0[3], f1[3];
#define KLD(d, slot) do { if ((d) < 8) { const LAS char* a_ = kb[(d)]; f0[slot] = *(const LAS bf16x8*)a_; f1[slot] = *(const LAS bf16x8*)(a_ + 32 * 256); } \
        else { const LAS char* a_ = kr + (((((d) - 8) * 2 + hi) ^ sw) << 4); f0[slot] = *(const LAS bf16x8*)a_; f1[slot] = *(const LAS bf16x8*)(a_ + 32 * 128); } } while (0)
    KLD(0, 0); KLD(1, 1); SBAR();
    __builtin_amdgcn_s_setprio(1);
#pragma unroll
    for (int d = 0; d < 12; ++d) {
        if (d + 2 < 12) KLD(d + 2, (d + 2) % 3);
        SBAR();
        p0 = __builtin_amdgcn_mfma_f32_32x32x16_bf16(f0[d % 3], qr[d], p0, 0, 0, 0);
        p1 = __builtin_amdgcn_mfma_f32_32x32x16_bf16(f1[d % 3], qr[d], p1, 0, 0, 0);
        SBAR();
    }
    __builtin_amdgcn_s_setprio(0);
#undef KLD
}
template <int VB, bool PIPE>
__device__ __forceinline__ void pv_tile(f32x16* o, int vb0, bf16x8 pa0, bf16x8 pa1, bf16x8 pa2, bf16x8 pa3) {
#define TRRD(dst, off) asm volatile("ds_read_b64_tr_b16 %0, %1 offset:%2" : "=&v"(dst) : "v"(vb0), "i"(off) : "memory")
#define PV_D0(d0) do { s16x4 l0, l1, l2, l3, h0, h1, h2, h3; constexpr int b_ = OFF_V + VB * SHM_V + v_rd_off(d0, 0, 0); \
        TRRD(l0, b_); TRRD(h0, b_ + 2048); TRRD(l1, b_ + 4096); TRRD(h1, b_ + 6144); TRRD(l2, b_ + 8192); TRRD(h2, b_ + 10240); TRRD(l3, b_ + 12288); TRRD(h3, b_ + 14336); \
        asm volatile("s_waitcnt lgkmcnt(0)" ::: "memory"); SBAR(); \
        o[d0] = __builtin_amdgcn_mfma_f32_32x32x16_bf16(pa0, (bf16x8){l0[0], l0[1], l0[2], l0[3], h0[0], h0[1], h0[2], h0[3]}, o[d0], 0, 0, 0); \
        o[d0] = __builtin_amdgcn_mfma_f32_32x32x16_bf16(pa1, (bf16x8){l1[0], l1[1], l1[2], l1[3], h1[0], h1[1], h1[2], h1[3]}, o[d0], 0, 0, 0); \
        o[d0] = __builtin_amdgcn_mfma_f32_32x32x16_bf16(pa2, (bf16x8){l2[0], l2[1], l2[2], l2[3], h2[0], h2[1], h2[2], h2[3]}, o[d0], 0, 0, 0); \
        o[d0] = __builtin_amdgcn_mfma_f32_32x32x16_bf16(pa3, (bf16x8){l3[0], l3[1], l3[2], l3[3], h3[0], h3[1], h3[2], h3[3]}, o[d0], 0, 0, 0); } while (0)
#define PV_RD(S_, d0) do { constexpr int b_ = OFF_V + VB * SHM_V + v_rd_off(d0, 0, 0); \
        TRRD(S_[0], b_); TRRD(S_[4], b_ + 2048); TRRD(S_[1], b_ + 4096); TRRD(S_[5], b_ + 6144); TRRD(S_[2], b_ + 8192); TRRD(S_[6], b_ + 10240); TRRD(S_[3], b_ + 12288); TRRD(S_[7], b_ + 14336); } while (0)
#define PV_MM(S_, d0) do { \
        o[d0] = __builtin_amdgcn_mfma_f32_32x32x16_bf16(pa0, (bf16x8){S_[0][0], S_[0][1], S_[0][2], S_[0][3], S_[4][0], S_[4][1], S_[4][2], S_[4][3]}, o[d0], 0, 0, 0); \
        o[d0] = __builtin_amdgcn_mfma_f32_32x32x16_bf16(pa1, (bf16x8){S_[1][0], S_[1][1], S_[1][2], S_[1][3], S_[5][0], S_[5][1], S_[5][2], S_[5][3]}, o[d0], 0, 0, 0); \
        o[d0] = __builtin_amdgcn_mfma_f32_32x32x16_bf16(pa2, (bf16x8){S_[2][0], S_[2][1], S_[2][2], S_[2][3], S_[6][0], S_[6][1], S_[6][2], S_[6][3]}, o[d0], 0, 0, 0); \
        o[d0] = __builtin_amdgcn_mfma_f32_32x32x16_bf16(pa3, (bf16x8){S_[3][0], S_[3][1], S_[3][2], S_[3][3], S_[7][0], S_[7][1], S_[7][2], S_[7][3]}, o[d0], 0, 0, 0); } while (0)
    __builtin_amdgcn_s_setprio(1);
    if constexpr (PIPE) {
        s16x4 fa[8], fb[8];
        PV_RD(fa, 0);
        PV_RD(fb, 1); asm volatile("s_waitcnt lgkmcnt(8)" ::: "memory"); SBAR(); PV_MM(fa, 0); SBAR();
        PV_RD(fa, 2); asm volatile("s_waitcnt lgkmcnt(8)" ::: "memory"); SBAR(); PV_MM(fb, 1); SBAR();
        PV_RD(fb, 3); asm volatile("s_waitcnt lgkmcnt(8)" ::: "memory"); SBAR(); PV_MM(fa, 2); SBAR();
        asm volatile("s_waitcnt lgkmcnt(0)" ::: "memory"); SBAR(); PV_MM(fb, 3);
    } else { PV_D0(0); PV_D0(1); PV_D0(2); PV_D0(3); }
    __builtin_amdgcn_s_setprio(0);
#undef PV_RD
#undef PV_MM
#undef PV_D0
#undef TRRD
}

template <int VB>
__device__ __forceinline__ float pv_fused(f32x16* o, int vb0, f32x16& p0, f32x16& p1) {
#define TRRD(dst, off) asm volatile("ds_read_b64_tr_b16 %0, %1 offset:%2" : "=&v"(dst) : "v"(vb0), "i"(off) : "memory")
#define PF_RD(S_, k) do { constexpr int b_ = OFF_V + VB * SHM_V + (k) * 4096; \
        TRRD(S_[0], b_ + v_rd_off(0, 0, 0)); TRRD(S_[4], b_ + v_rd_off(0, 0, 1)); TRRD(S_[1], b_ + v_rd_off(1, 0, 0)); TRRD(S_[5], b_ + v_rd_off(1, 0, 1)); \
        TRRD(S_[2], b_ + v_rd_off(2, 0, 0)); TRRD(S_[6], b_ + v_rd_off(2, 0, 1)); TRRD(S_[3], b_ + v_rd_off(3, 0, 0)); TRRD(S_[7], b_ + v_rd_off(3, 0, 1)); } while (0)
#define PF_MM(S_, PA) do { _Pragma("unroll") for (int d0 = 0; d0 < 4; ++d0) \
        o[d0] = __builtin_amdgcn_mfma_f32_32x32x16_bf16(PA, (bf16x8){S_[d0][0], S_[d0][1], S_[d0][2], S_[d0][3], S_[4 + d0][0], S_[4 + d0][1], S_[4 + d0][2], S_[4 + d0][3]}, o[d0], 0, 0, 0); } while (0)
#define PF_EXP(P, B_, OUT) do { _Pragma("unroll") for (int r = 0; r < 8; ++r) { P[B_ + r] = __builtin_amdgcn_exp2f(P[B_ + r]); ps += P[B_ + r]; } \
        unsigned a0 = cvtpk(P[B_+0], P[B_+1]), a1 = cvtpk(P[B_+2], P[B_+3]); unsigned b0 = cvtpk(P[B_+4], P[B_+5]), b1 = cvtpk(P[B_+6], P[B_+7]); \
        auto r0 = __builtin_amdgcn_permlane32_swap(a0, b0, false, false); auto r1 = __builtin_amdgcn_permlane32_swap(a1, b1, false, false); \
        u32x4 w = {r0[0], r1[0], r0[1], r1[1]}; OUT = __builtin_bit_cast(bf16x8, w); } while (0)
    float ps = 0.f; s16x4 fa[8], fb[8]; bf16x8 pa, pb;
    PF_RD(fa, 0);
    PF_EXP(p0, 0, pa); SBAR();
    PF_RD(fb, 1); asm volatile("s_waitcnt lgkmcnt(8)" ::: "memory"); SBAR();
    __builtin_amdgcn_s_setprio(1); PF_MM(fa, pa); __builtin_amdgcn_s_setprio(0); SBAR();
    PF_EXP(p0, 8, pb); SBAR();
    PF_RD(fa, 2); asm volatile("s_waitcnt lgkmcnt(8)" ::: "memory"); SBAR();
    __builtin_amdgcn_s_setprio(1); PF_MM(fb, pb); __builtin_amdgcn_s_setprio(0); SBAR();
    PF_EXP(p1, 0, pa); SBAR();
    PF_RD(fb, 3); asm volatile("s_waitcnt lgkmcnt(8)" ::: "memory"); SBAR();
    __builtin_amdgcn_s_setprio(1); PF_MM(fa, pa); __builtin_amdgcn_s_setprio(0); SBAR();
    PF_EXP(p1, 8, pb); SBAR();
    asm volatile("s_waitcnt lgkmcnt(0)" ::: "memory"); SBAR();
    __builtin_amdgcn_s_setprio(1); PF_MM(fb, pb); __builtin_amdgcn_s_setprio(0);
#undef PF_EXP
#undef PF_MM
#undef PF_RD
#undef TRRD
    return ps;
}

constexpr int WS_BUF = 90112;
constexpr int WT_WGU1 = 16 * 32, WT_WD1 = 16 * 16, WT1 = NE * WT_WGU1, WT2 = WT1 + NE * WT_WD1;
struct WStream { const float* w_gu; const float* w_down; unsigned char* dgu; unsigned char* dd; int it0, stride, total; int pos;
    const char* isrc; int ish; unsigned char* cdst; };
constexpr int WKSH = 11;
__device__ __forceinline__ void wdecode_src(WStream& W, int it) {
    if (it < WT1) { const int e = it / WT_WGU1, q = it % WT_WGU1, k0 = (q / 32) * 128, n0 = (q % 32) * 128; W.isrc = (const char*)(W.w_gu + (size_t)e * DM * (2 * FF) + (size_t)k0 * (2 * FF) + n0); W.ish = 14; }
    else { const int r = it - WT1, e = r / WT_WD1, q = r % WT_WD1, k0 = (q / 16) * 128, n0 = (q % 16) * 128; W.isrc = (const char*)(W.w_down + (size_t)e * FF * DM + (size_t)k0 * DM + n0); W.ish = 13; }
}
__device__ __forceinline__ void wdecode_dst(WStream& W, int it) {
    if (it < WT1) { const int e = it / WT_WGU1, q = it % WT_WGU1, k0 = (q / 32) * 128, n0 = (q % 32) * 128, drow0 = ((n0 % FF) / 128) * 256 + (n0 / FF) * 128; W.cdst = W.dgu + (size_t)e * (2 * FF) * DM + ((size_t)drow0 << WKSH) + k0; }
    else { const int r = it - WT1, e = r / WT_WD1, q = r % WT_WD1, k0 = (q / 16) * 128, n0 = (q % 16) * 128; W.cdst = W.dd + (size_t)e * DM * FF + ((size_t)n0 << WKSH) + k0; }
}
__device__ __forceinline__ void w_issue(WStream& W, LAS char* lds, int wv, int hi, int r32, int q) {
    const int qq = q < W.total ? q : W.total - 1, j = qq & 3;
    if (j == 0 || q == 0) wdecode_src(W, W.it0 + (qq >> 2) * W.stride);
    const unsigned voff = ((unsigned)(hi + wv * 4) << W.ish) + ((unsigned)r32 << 4);
    const char* b0 = W.isrc + ((size_t)(32 * j) << W.ish); const char* b1 = b0 + ((size_t)2 << W.ish);
    const int la0 = (int)(uintptr_t)lds + WS_BUF + j * 16384 + wv * 2048, la1 = la0 + 1024;
    asm volatile("s_mov_b32 m0, %2\n\ts_nop 0\n\tglobal_load_lds_dwordx4 %0, %1 nt" :: "v"(voff), "s"(b0), "s"(la0) : "memory", "m0");
    asm volatile("s_mov_b32 m0, %2\n\ts_nop 0\n\tglobal_load_lds_dwordx4 %0, %1 nt" :: "v"(voff), "s"(b1), "s"(la1) : "memory", "m0");
}
__device__ __forceinline__ void w_convert(WStream& W, LAS char* lds, int wv, int hi, int r32, int q) {
    const int qq = q < W.total ? q : W.total - 1, j = qq & 3;
    if (j == 0 || q == 0) wdecode_dst(W, W.it0 + (qq >> 2) * W.stride);
    const int on = (wv & 1) * 64 + hi * 32 + r32, oq = wv >> 1;
    const LAS float* scr = (const LAS float*)(lds + WS_BUF + j * 16384 + oq * 4096) + on;
    float f[8];
#pragma unroll
    for (int i = 0; i < 8; ++i) f[i] = scr[i * 128];
    asm volatile("s_waitcnt lgkmcnt(0)" : "+v"(f[0]), "+v"(f[1]), "+v"(f[2]), "+v"(f[3]), "+v"(f[4]), "+v"(f[5]), "+v"(f[6]), "+v"(f[7]));
    typedef short v2s_ __attribute__((ext_vector_type(2)));
    v2s_ q0 = {0, 0}, q1 = {0, 0};
    q0 = __builtin_amdgcn_cvt_scalef32_pk_fp8_f32(q0, f[0], f[1], 1.0f / WSCALE, false); q0 = __builtin_amdgcn_cvt_scalef32_pk_fp8_f32(q0, f[2], f[3], 1.0f / WSCALE, true);
    q1 = __builtin_amdgcn_cvt_scalef32_pk_fp8_f32(q1, f[4], f[5], 1.0f / WSCALE, false); q1 = __builtin_amdgcn_cvt_scalef32_pk_fp8_f32(q1, f[6], f[7], 1.0f / WSCALE, true);
    const u32x2 w = (u32x2){__builtin_bit_cast(unsigned, q0), __builtin_bit_cast(unsigned, q1)};
    const unsigned soff = (unsigned)on << WKSH; unsigned char* sb = W.cdst + 32 * j + oq * 8;
    asm volatile("global_store_dwordx2 %0, %1, %2" :: "v"(soff), "v"(w), "s"(sb) : "memory");
}

struct Tensors { const bf16* Q; const bf16* K; const bf16* V; unsigned char* O; const float* cs; const float* gq; };

template <bool NOMAX>
__device__ __forceinline__ void attn_unit(const Tensors& X, int b, int h, int qb, LAS char* lds, WStream& W, int wave) {
    int tid = TID_NOW(wave); asm volatile("" : "+v"(tid));
    const int wid = __builtin_amdgcn_readfirstlane(tid >> 6), lane = tid & 63, r32 = lane & 31, hi = lane >> 5;
    bf16x8 qr[12];
    {
        const size_t trow = (size_t)b * SEQ + (size_t)qb * 256 + wid * 32 + r32;
        const bf16* qp = X.Q + trow * 1536 + h * DQK + hi * 8;
#pragma unroll
        for (int d0 = 0; d0 < 12; ++d0) qr[d0] = *(const bf16x8*)(qp + d0 * 16);
        float ss = 0.f;
#pragma unroll
        for (int d0 = 0; d0 < 12; ++d0) { float f[8]; unpack8(qr[d0], f);
#pragma unroll
            for (int j = 0; j < 8; ++j) ss += f[j] * f[j]; }
        ss += __shfl_xor(ss, 32);
        const float rs = __builtin_amdgcn_rsqf(ss * (1.0f / DQK) + EPS) ;
        const float* gq = X.gq + hi * 8;
#pragma unroll
        for (int d0 = 0; d0 < 8; ++d0) { float f[8]; unpack8(qr[d0], f); const f32x4 g0 = *(const f32x4*)(gq + d0 * 16), g1 = *(const f32x4*)(gq + d0 * 16 + 4);
#pragma unroll
            for (int j = 0; j < 4; ++j) { f[j] *= rs * g0[j] * QSCALE; f[4 + j] *= rs * g1[j] * QSCALE; }
            qr[d0] = pack8f(f); }
        const float* csr = X.cs + trow * 64 + hi * 8;
#pragma unroll
        for (int g = 0; g < 2; ++g) {
            float x1[8], x2[8]; unpack8(qr[8 + g], x1); unpack8(qr[10 + g], x2);
            const f32x4 ga0 = *(const f32x4*)(gq + (8 + g) * 16), ga1 = *(const f32x4*)(gq + (8 + g) * 16 + 4), gb0 = *(const f32x4*)(gq + (10 + g) * 16), gb1 = *(const f32x4*)(gq + (10 + g) * 16 + 4);
            const f32x4 c0 = *(const f32x4*)(csr + g * 16), c1 = *(const f32x4*)(csr + g * 16 + 4), s0 = *(const f32x4*)(csr + 32 + g * 16), s1 = *(const f32x4*)(csr + 32 + g * 16 + 4);
            float o1[8], o2[8];
#pragma unroll
            for (int j = 0; j < 8; ++j) { const float ga = j < 4 ? ga0[j & 3] : ga1[j & 3], gb = j < 4 ? gb0[j & 3] : gb1[j & 3], c = j < 4 ? c0[j & 3] : c1[j & 3], s = j < 4 ? s0[j & 3] : s1[j & 3];
                const float a = x1[j] * rs * ga, bb = x2[j] * rs * gb;
                o1[j] = (a * c - bb * s) * QSCALE; o2[j] = (bb * c + a * s) * QSCALE; }
            qr[8 + g] = pack8f(o1); qr[10 + g] = pack8f(o2);
        }
    }
    const int NT = 4 * (qb + 1);
    const int qlo = qb * 256 + wid * 32, qm = qlo + r32 - 4 * hi;
    const int grp = wid >> 2;
    LAS float* al_l = (LAS float*)(lds + OFF_WS) + wid * 64 + 32;
    float l_reg = 0.f; f32x16 o[4] = {};
    f32x16 negm = {};
    const int sr = tid >> 4, sc = (tid & 15) * 8, vst0 = v_st(sr, sc), vst1 = v_st(32 + sr, sc), kws = KSWZ(sr, sc * 2);
    const int krk = tid >> 3, krc = tid & 7, krw = krk * 128 + ((krc ^ ((krk >> 1) & 7)) << 4);
    const int vb0 = (int)(uintptr_t)lds + v_rd_base(lane);
    const bf16* Kg = X.K + (size_t)b * SEQ * 1536 + h * DQK;
    const bf16* Vg = X.V + (size_t)b * SEQ * 2048 + h * 256;
    const int ko0 = sr * 1536 + sc, kro = krk * 1536 + NOPE + krc * 8, vo0 = sr * 2048 + sc;
    bf16x8 st_k0, st_k1, st_kr, st_v0, st_v1;
#define SLOADK(t) do { const bf16* kt_ = Kg + (size_t)(t) * (KVBLK * 1536); \
        st_k0 = *(const bf16x8*)(kt_ + ko0); st_k1 = *(const bf16x8*)(kt_ + ko0 + 32 * 1536); st_kr = *(const bf16x8*)(kt_ + kro); } while (0)
#define SLOADV(t) do { const bf16* vt_ = Vg + (size_t)(t) * (KVBLK * 2048); \
        st_v0 = *(const bf16x8*)(vt_ + vo0); st_v1 = *(const bf16x8*)(vt_ + vo0 + 32 * 2048); } while (0)
#define DSW128(addr, off, val) asm volatile("ds_write_b128 %0, %1 offset:%2" :: "v"(addr), "v"(val), "i"(off))
    const int lbase = (int)(uintptr_t)lds, kwa = lbase + kws, krwa = lbase + OFF_KR + krw, vsa0 = lbase + vst0, vsa1 = lbase + vst1;
#define SWRITEK(bf) do { DSW128(kwa, OFF_KN + (bf) * SHM_KN, st_k0); DSW128(kwa, OFF_KN + (bf) * SHM_KN + 32 * 256, st_k1); DSW128(krwa, (bf) * SHM_KR, st_kr); } while (0)
#define SWRITEV(bf) do { DSW128(vsa0, OFF_V + (bf) * SHM_V, st_v0); DSW128(vsa1, OFF_V + (bf) * SHM_V, st_v1); } while (0)
#define LBAR() do { asm volatile("s_waitcnt lgkmcnt(0)" ::: "memory"); __builtin_amdgcn_s_barrier(); } while (0)
#define PK4(P, B_, OUT) do { unsigned a0 = cvtpk(P[B_+0], P[B_+1]), a1 = cvtpk(P[B_+2], P[B_+3]); \
        unsigned b0 = cvtpk(P[B_+4], P[B_+5]), b1 = cvtpk(P[B_+6], P[B_+7]); \
        auto r0 = __builtin_amdgcn_permlane32_swap(a0, b0, false, false); auto r1 = __builtin_amdgcn_permlane32_swap(a1, b1, false, false); \
        u32x4 w = {r0[0], r1[0], r0[1], r1[1]}; OUT = __builtin_bit_cast(bf16x8, w); } while (0)
    constexpr float THR2 = 11.5f;
    f32x16 p0, p1; bf16x8 pa0, pa1, pa2, pa3; float alpha = 1.f, dsh = 0.f; bool resc = false;
#define TILE_STEP(t, BUF) do { \
          \
        if ((t) + 1 < NT) SWRITEK((BUF) ^ 1); SLOADK((t) + 2 < NT ? (t) + 2 : NT - 1);   \
        SBAR(); qkt<BUF>(p0, p1, lds, r32, hi, qr, negm); \
        { const int kb_ = (t) * KVBLK; if (kb_ + KVBLK - 1 > qlo) mask_tile(p0, p1, qm - kb_); } \
        if constexpr (!NOMAX) { float pmax = p0[0]; _Pragma("unroll") for (int r = 1; r < 16; ++r) pmax = fmaxf(pmax, p0[r]); _Pragma("unroll") for (int r = 0; r < 16; ++r) pmax = fmaxf(pmax, p1[r]); \
          { auto rr = __builtin_amdgcn_permlane32_swap(__float_as_uint(pmax), __float_as_uint(pmax), false, false); pmax = fmaxf(__uint_as_float(rr[0]), __uint_as_float(rr[1])); } \
          if (__all(pmax <= THR2)) { alpha = 1.f; resc = false; dsh = 0.f; } \
          else { dsh = fmaxf(pmax, 0.f); alpha = __builtin_amdgcn_exp2f(-dsh); resc = true; \
              _Pragma("unroll") for (int r = 0; r < 16; ++r) negm[r] -= dsh; } } \
          \
        if ((t) + 1 < NT) SWRITEV((BUF) ^ 1); SLOADV((t) + 2 < NT ? (t) + 2 : NT - 1); \
        if (W.pos < W.total + 3) {   \
            asm volatile("s_waitcnt vmcnt(12)" ::: "memory");   \
            if (W.pos >= 3) w_convert(W, lds, wid, hi, r32, W.pos - 3); \
            w_issue(W, lds, wid, hi, r32, W.pos); ++W.pos; } \
        if constexpr (NOMAX) { SBAR(); float ps = pv_fused<BUF>(o, vb0, p0, p1); \
          { auto rr = __builtin_amdgcn_permlane32_swap(__float_as_uint(ps), __float_as_uint(ps), false, false); ps = __uint_as_float(rr[0]) + __uint_as_float(rr[1]); } \
          l_reg += ps; } \
        else { \
        if (resc) { _Pragma("unroll") for (int r = 0; r < 16; ++r) { p0[r] -= dsh; p1[r] -= dsh; } } \
        _Pragma("unroll") for (int r = 0; r < 16; ++r) { p0[r] = __builtin_amdgcn_exp2f(p0[r]); p1[r] = __builtin_amdgcn_exp2f(p1[r]); } \
        { float ps = 0.f; _Pragma("unroll") for (int r = 0; r < 16; ++r) ps += p0[r]; _Pragma("unroll") for (int r = 0; r < 16; ++r) ps += p1[r]; \
          { auto rr = __builtin_amdgcn_permlane32_swap(__float_as_uint(ps), __float_as_uint(ps), false, false); ps = __uint_as_float(rr[0]) + __uint_as_float(rr[1]); } \
          l_reg = l_reg * alpha + ps; } \
        if (resc) { if (hi == 0) al_l[r32] = alpha; asm volatile("s_waitcnt lgkmcnt(0)" ::: "memory"); \
            _Pragma("unroll") for (int d_ = 0; d_ < 4; ++d_) _Pragma("unroll") for (int r = 0; r < 16; ++r) o[d_][r] *= al_l[crow(r, hi)]; } \
        PK4(p0, 0, pa0); PK4(p0, 8, pa1); PK4(p1, 0, pa2); PK4(p1, 8, pa3); \
        SBAR(); pv_tile<BUF, false>(o, vb0, pa0, pa1, pa2, pa3); } \
        LBAR(); } while (0)
    SLOADK(0); SLOADV(0); asm volatile("s_waitcnt vmcnt(0)" ::: "memory"); SWRITEK(0); SWRITEV(0);
    SLOADK(1); SLOADV(1);
    LBAR();
    (void)grp;
    for (int t = 0; t < NT; t += 2) {
        TILE_STEP(t, 0);
        TILE_STEP(t + 1, 1);
    }
#undef TILE_STEP
#undef PK4
#undef SLOADK
#undef SLOADV
#undef SWRITEK
#undef SWRITEV
#undef DSW128
    {
        int tz = TID_NOW(wave); asm volatile("" : "+v"(tz));
        const int wid2 = __builtin_amdgcn_readfirstlane(tz >> 6), lane2 = tz & 63, r32b = lane2 & 31, hib = lane2 >> 5;
        LAS float* li2 = (LAS float*)(lds + OFF_WS) + wid2 * 64;
        if (hib == 0) li2[r32b] = l_reg; asm volatile("s_waitcnt lgkmcnt(0)" ::: "memory");
        unsigned char* Ow = X.O + ((size_t)b * SEQ + (size_t)qb * 256 + wid2 * 32 + 4 * hib) * 2048 + h * DV + r32b;
#pragma unroll
        for (int r = 0; r < 16; ++r) { const int c0 = (r & 3) + 8 * (r >> 2); const float rli = __builtin_amdgcn_rcpf(li2[c0 + 4 * hib]);
            float v[4]; float sq = 0.f;
#pragma unroll
            for (int d0 = 0; d0 < 4; ++d0) { v[d0] = o[d0][r] * rli; sq += v[d0] * v[d0]; }
#pragma unroll
            for (int off = 1; off < 32; off <<= 1) sq += __shfl_xor(sq, off);
            const float rn = __builtin_amdgcn_rsqf(sq * (1.0f / DV) + EPS) * MSCALE;
#pragma unroll
            for (int d0 = 0; d0 < 4; ++d0) { const float vv = v[d0] * rn; const float vn = __shfl_xor(vv, 1);
                const int pk = __builtin_amdgcn_cvt_pk_fp8_f32(vv, vn, 0, false) & 0xffff; const int pq = __shfl_xor(pk, 2);
                if ((r32b & 3) == 0) *(unsigned*)(Ow + (size_t)c0 * 2048 + d0 * 32) = (unsigned)(pk | (pq << 16)); } }

    }
    LBAR();
#undef LBAR
}
#undef KSWZ
#undef SBAR
}

struct Args {
    const float* x; const float* c; const int* pos; const float* w_ada; const float* b_ada; const float* norm_mix_g;
    const float* w_in; const float* conv_w; const float* q_lat_g; const float* w_uq; const float* kv_lat_g; const float* w_ukv;
    const float* q_head_g; const float* k_head_g; const float* conv_out_g; const float* mla_out_g; const float* w_out;
    const float* norm_ffn_g; const float* router_w; const float* router_b; const float* w_gu; const float* b_gu; const float* w_down; const float* b_down;
    float* out; unsigned char* ws;
    float invf[32];
    int ph_lo, ph_hi;
};

constexpr int IT_WIN = 16 * 138, IT_WUQ = 6 * 48, IT_WUKV = 4 * 64, IT_WOUT = 16 * 64, IT_WGU1 = 16 * 128, IT_WD1 = 16 * 64;
constexpr int IT0 = 0, IT1 = IT0 + IT_WIN, IT2 = IT1 + IT_WUQ, IT3 = IT2 + IT_WUKV, IT4 = IT3 + IT_WOUT;
constexpr int LT0 = 0, LT1 = LT0 + NE * IT_WGU1, LT2 = LT1 + NE * IT_WD1;
struct CvtItem { const float* src; int N; int K; int k0; int n0; unsigned char* dst; int drow0; const float* gain; int fp8; };
__device__ __forceinline__ CvtItem cvt_decode_early(const Args& a, int it) {
    CvtItem c; unsigned char* ws = a.ws; c.fp8 = 0; c.gain = nullptr;
    if (it < IT1) { const int r = it - IT0; c.src = a.w_in; c.N = DIN; c.K = DM; c.k0 = (r / 138) * 128; c.n0 = (r % 138) * 32; c.dst = ws + WS_WIN; }
    else if (it < IT2) { const int r = it - IT1; c.src = a.w_uq; c.N = NH * DQK; c.K = QLORA; c.k0 = (r / 48) * 128; c.n0 = (r % 48) * 32; c.dst = ws + WS_WUQ; c.gain = a.q_lat_g; }
    else if (it < IT3) { const int r = it - IT2; c.src = a.w_ukv; c.N = NH * 256; c.K = KVLORA; c.k0 = (r / 64) * 128; c.n0 = (r % 64) * 32; c.dst = ws + WS_WUKV; c.gain = a.kv_lat_g; }
    else { const int r = it - IT3; c.src = a.w_out; c.N = DM; c.K = DM; c.k0 = (r / 64) * 128; c.n0 = (r % 64) * 32; c.dst = ws + WS_WOUT; c.gain = c.k0 < CONVD ? a.conv_out_g : a.mla_out_g - CONVD; c.fp8 = 1; }
    c.drow0 = c.n0;
    return c;
}
__device__ __forceinline__ CvtItem cvt_decode_late(const Args& a, int it) {
    CvtItem c; unsigned char* ws = a.ws; c.fp8 = 1; c.gain = nullptr;
    if (it < LT1) { const int e = it / IT_WGU1, q = it % IT_WGU1; c.src = a.w_gu + (size_t)e * DM * (2 * FF); c.N = 2 * FF; c.K = DM; c.k0 = (q / 128) * 128; c.n0 = (q % 128) * 32;
        c.dst = ws + WS_WGU + (size_t)e * (2 * FF) * DM; c.drow0 = ((c.n0 % FF) / 128) * 256 + (c.n0 / FF) * 128 + (c.n0 % 128); }
    else { const int r = it - LT1, e = r / IT_WD1, q = r % IT_WD1; c.src = a.w_down + (size_t)e * FF * DM; c.N = DM; c.K = FF; c.k0 = (q / 64) * 128; c.n0 = (q % 64) * 32;
        c.dst = ws + WS_WD + (size_t)e * DM * FF; c.drow0 = c.n0; }
    return c;
}
template <bool LATE, int MODE = 0>
__device__ __forceinline__ void cvt_wave(const Args& a, LAS float* scr, int lane, int it0, int itend, int stride) {
    const int lr = lane >> 3, lc = (lane & 7) * 4;
    const int on = lane >> 1, oh = lane & 1;
    f32x4 v[16];
    int it = it0;
    if (it < itend) { const CvtItem c = LATE ? cvt_decode_late(a, it) : cvt_decode_early(a, it); const float* sp = c.src + (size_t)(c.k0 + lr) * c.N + c.n0 + lc;
#pragma unroll
        for (int j = 0; j < 16; ++j) v[j] = LATE ? __builtin_nontemporal_load((const f32x4*)(sp + (size_t)(j * 8) * c.N)) : *(const f32x4*)(sp + (size_t)(j * 8) * c.N); }
    while (it < itend) {
        const CvtItem c = LATE ? cvt_decode_late(a, it) : cvt_decode_early(a, it);
        if (MODE == 2) {
#pragma unroll
            for (int j = 0; j < 16; ++j) asm volatile("" :: "v"(v[j]));
            const int nx2 = it + stride;
            if (nx2 < itend) { const CvtItem cn = cvt_decode_late(a, nx2); const float* sp = cn.src + (size_t)(cn.k0 + lr) * cn.N + cn.n0 + lc;
#if PROBE_CVT == 3
                const float* sq = a.w_gu + (size_t)nx2 * 4096 + lane * 4;
#pragma unroll
                for (int j = 0; j < 16; ++j) v[j] = __builtin_nontemporal_load((const f32x4*)(sq + j * 256));
#elif PROBE_CVT == 4
                const float* sq = cn.src + (size_t)((cn.k0 / 4) + (lane >> 5)) * cn.N + (cn.n0 % 1024) * 4 + (lane & 31) * 4;
#pragma unroll
                for (int j = 0; j < 16; ++j) v[j] = __builtin_nontemporal_load((const f32x4*)(sq + (size_t)(j * 2) * cn.N));
#else
#pragma unroll
                for (int j = 0; j < 16; ++j) v[j] = __builtin_nontemporal_load((const f32x4*)(sp + (size_t)(j * 8) * cn.N));
#endif
            }
            it = nx2; continue; }
        if (!LATE && c.gain) {
#pragma unroll
            for (int j = 0; j < 16; ++j) v[j] = v[j] * c.gain[c.k0 + j * 8 + lr]; }
#pragma unroll
        for (int j = 0; j < 16; ++j)
#pragma unroll
            for (int q = 0; q < 4; ++q) scr[(j * 8 + lr) * 33 + lc + q] = v[j][q];
        const int nx = it + stride;
        if (nx < itend) { const CvtItem cn = LATE ? cvt_decode_late(a, nx) : cvt_decode_early(a, nx); const float* sp = cn.src + (size_t)(cn.k0 + lr) * cn.N + cn.n0 + lc;
#pragma unroll
            for (int j = 0; j < 16; ++j) v[j] = LATE ? __builtin_nontemporal_load((const f32x4*)(sp + (size_t)(j * 8) * cn.N)) : *(const f32x4*)(sp + (size_t)(j * 8) * cn.N); }
        asm volatile("s_waitcnt lgkmcnt(0)" ::: "memory");
        if (LATE || c.fp8) {
            unsigned char* dp = c.dst + (size_t)(c.drow0 + on) * c.K + c.k0 + oh * 64;
#pragma unroll
            for (int g = 0; g < 4; ++g) { float f[16];
#pragma unroll
                for (int j = 0; j < 16; ++j) f[j] = scr[(oh * 64 + g * 16 + j) * 33 + on] * WSCALE;
                const u32x4 w = {pg8::pk_fp8x4(f[0], f[1], f[2], f[3]), pg8::pk_fp8x4(f[4], f[5], f[6], f[7]), pg8::pk_fp8x4(f[8], f[9], f[10], f[11]), pg8::pk_fp8x4(f[12], f[13], f[14], f[15])};
                __builtin_nontemporal_store(w, (u32x4*)(dp + g * 16)); }
        } else {
            bf16* dp = (bf16*)c.dst + (size_t)(c.drow0 + on) * c.K + c.k0 + oh * 64;
#pragma unroll
            for (int g = 0; g < 8; ++g) { float f[8];
#pragma unroll
                for (int j = 0; j < 8; ++j) f[j] = scr[(oh * 64 + g * 8 + j) * 33 + on];
                *(bf16x8*)(dp + g * 8) = pack8f(f); }
        }
        asm volatile("s_waitcnt lgkmcnt(0)" ::: "memory");
        it = nx;
    }
}

constexpr int BT_WGU1 = 16 * 16, BT_WD1 = 16 * 8, BT1 = NE * BT_WGU1, BT2 = BT1 + NE * BT_WD1;
struct BItem { const float* src; int N; int K; int k0; int n0; unsigned char* dst; int gu; };
__device__ __forceinline__ BItem bcvt_decode(const Args& a, int it) {
    BItem c; unsigned char* ws = a.ws;
    if (it < BT1) { const int e = it / BT_WGU1, q = it % BT_WGU1; c.src = a.w_gu + (size_t)e * DM * (2 * FF); c.N = 2 * FF; c.K = DM; c.k0 = (q / 16) * 128; c.n0 = (q % 16) * 256; c.dst = ws + WS_WGU + (size_t)e * (2 * FF) * DM; c.gu = 1; }
    else { const int r = it - BT1, e = r / BT_WD1, q = r % BT_WD1; c.src = a.w_down + (size_t)e * FF * DM; c.N = DM; c.K = FF; c.k0 = (q / 8) * 128; c.n0 = (q % 8) * 256; c.dst = ws + WS_WD + (size_t)e * DM * FF; c.gu = 0; }
    return c;
}
__device__ __forceinline__ void bcvt_block(const Args& a, LAS float* scr, int tid, int it0, int itend, int stride) {
    const int wv = tid >> 6, ln = tid & 63;
    const int on = tid >> 1, oh = tid & 1;
    f32x4 va[16], vb[16];
#define BLOAD(V, IT) do { if ((IT) < itend) { const BItem c_ = bcvt_decode(a, (IT)); const float* sp_ = c_.src + (size_t)(c_.k0 + wv) * c_.N + c_.n0 + ln * 4; \
        _Pragma("unroll") for (int j = 0; j < 16; ++j) V[j] = *(const f32x4*)(sp_ + (size_t)(j * 8) * c_.N); } } while (0)
#define BSTEP(V, IT, ITNEXT) do { const BItem c = bcvt_decode(a, (IT)); \
        __syncthreads(); \
        _Pragma("unroll") for (int j = 0; j < 16; ++j) *(LAS f32x4*)(scr + (j * 8 + wv) * 260 + ln * 4) = V[j]; \
        BLOAD(V, ITNEXT); \
        __syncthreads(); \
        const int n = c.n0 + on; \
        const int drow = c.gu ? ((n % FF) / 128) * 256 + (n / FF) * 128 + (n % 128) : n; \
        unsigned char* dp = c.dst + (size_t)drow * c.K + c.k0 + oh * 64; \
        _Pragma("unroll") for (int g = 0; g < 4; ++g) { float f[16]; \
            _Pragma("unroll") for (int j = 0; j < 16; ++j) f[j] = scr[(oh * 64 + g * 16 + j) * 260 + on] * WSCALE; \
            const u32x4 w = {pg8::pk_fp8x4(f[0], f[1], f[2], f[3]), pg8::pk_fp8x4(f[4], f[5], f[6], f[7]), pg8::pk_fp8x4(f[8], f[9], f[10], f[11]), pg8::pk_fp8x4(f[12], f[13], f[14], f[15])}; \
            *(u32x4*)(dp + g * 16) = w; } } while (0)
    int it = it0;
    BLOAD(va, it); BLOAD(vb, it + stride);
    while (it < itend) {
        BSTEP(va, it, it + 2 * stride);
        if (it + stride < itend) BSTEP(vb, it + stride, it + 3 * stride);
        it += 2 * stride;
    }
#undef BLOAD
#undef BSTEP
    __syncthreads();
}

constexpr int DT_WGU1 = 16 * 32, DT_WD1 = 16 * 16, DT1 = NE * DT_WGU1, DT2 = DT1 + NE * DT_WD1;
struct DItem { const float* src; int N; int K; int k0; int n0; unsigned char* dst; int drow0; };
__device__ __forceinline__ DItem dcvt_decode(const Args& a, int it) {
    DItem c; unsigned char* ws = a.ws;
    if (it < DT1) { const int e = it / DT_WGU1, q = it % DT_WGU1; c.src = a.w_gu + (size_t)e * DM * (2 * FF); c.N = 2 * FF; c.K = DM; c.k0 = (q / 32) * 128; c.n0 = (q % 32) * 128;
        c.dst = ws + WS_WGU + (size_t)e * (2 * FF) * DM; c.drow0 = ((c.n0 % FF) / 128) * 256 + (c.n0 / FF) * 128; }
    else { const int r = it - DT1, e = r / DT_WD1, q = r % DT_WD1; c.src = a.w_down + (size_t)e * FF * DM; c.N = DM; c.K = FF; c.k0 = (q / 16) * 128; c.n0 = (q % 16) * 128;
        c.dst = ws + WS_WD + (size_t)e * DM * FF; c.drow0 = c.n0; }
    return c;
}
__device__ __forceinline__ void bcvt_dma(const Args& a, LAS unsigned char* lds, int tid, int it0, int itend, int stride) {
    const int wv = __builtin_amdgcn_readfirstlane(tid >> 6), ln = tid & 63;
    const int on = tid & 127, oq = tid >> 7;
#define DISSUE(IT, BUF) do { const DItem c_ = dcvt_decode(a, (IT)); const float* sp_ = c_.src + (size_t)(c_.k0 + wv * 16 + (ln >> 5)) * c_.N + c_.n0 + (ln & 31) * 4; \
        _Pragma("unroll") for (int i = 0; i < 8; ++i) __builtin_amdgcn_global_load_lds((const unsigned*)(sp_ + (size_t)(2 * i) * c_.N), (LAS unsigned*)(lds + (BUF) * 65536 + (wv * 8 + i) * 1024), 16, 0, 0); } while (0)
    int it = it0, buf = 0; bool first = true;
    if (it < itend) DISSUE(it, 0);
    while (it < itend) {
        const int nx = it + stride; const bool has_next = nx < itend;
        if (has_next) DISSUE(nx, buf ^ 1);
        if (has_next) { if (first) asm volatile("s_waitcnt vmcnt(8)" ::: "memory"); else asm volatile("s_waitcnt vmcnt(10)" ::: "memory"); }
        else asm volatile("s_waitcnt vmcnt(0)" ::: "memory");
        __builtin_amdgcn_s_barrier();
        const DItem c = dcvt_decode(a, it);
        const LAS float* scr = (const LAS float*)(lds + buf * 65536) + (oq * 32) * 128 + on;
        float f[32];
#pragma unroll
        for (int j = 0; j < 32; ++j) f[j] = scr[j * 128] * WSCALE;
        unsigned char* dp = c.dst + (size_t)(c.drow0 + on) * c.K + c.k0 + oq * 32;
        const u32x4 w0 = {pg8::pk_fp8x4(f[0], f[1], f[2], f[3]), pg8::pk_fp8x4(f[4], f[5], f[6], f[7]), pg8::pk_fp8x4(f[8], f[9], f[10], f[11]), pg8::pk_fp8x4(f[12], f[13], f[14], f[15])};
        const u32x4 w1 = {pg8::pk_fp8x4(f[16], f[17], f[18], f[19]), pg8::pk_fp8x4(f[20], f[21], f[22], f[23]), pg8::pk_fp8x4(f[24], f[25], f[26], f[27]), pg8::pk_fp8x4(f[28], f[29], f[30], f[31])};
        *(u32x4*)dp = w0; *(u32x4*)(dp + 16) = w1;
        asm volatile("s_waitcnt lgkmcnt(0)" ::: "memory");
        __builtin_amdgcn_s_barrier();
        it = nx; buf ^= 1; first = false;
    }
#undef DISSUE
    asm volatile("s_waitcnt vmcnt(0)" ::: "memory");
    __builtin_amdgcn_s_barrier();
}

__global__ void __launch_bounds__(512, 2) fwd(Args a) {
    extern __shared__ __attribute__((aligned(16))) unsigned char lds_raw[];
    LAS unsigned char* lds = (LAS unsigned char*)lds_raw;
    volatile LAS unsigned* MISC = (volatile LAS unsigned*)(lds + MISC_OFF);
    const int wave = __builtin_amdgcn_readfirstlane((int)threadIdx.x >> 6);
    const int G = gridDim.x, bid = blockIdx.x;
#define PH_IDS int tid = TID_NOW(wave); asm volatile("" : "+v"(tid)); const int lane = tid & 63; (void)lane;
    const int gw = bid * 8 + wave, NGW = G * 8;
    unsigned char* ws = a.ws;
    gu32* ctl = (gu32*)(ws + WS_CTL);
    { PH_IDS for (int u = tid; u < (LDS_BYTES - LDSCTL_OFF) / 4; u += 512) ((LAS unsigned*)(lds + LDSCTL_OFF))[u] = 0u; }
    __syncthreads();
    const int lo = a.ph_lo, hi = a.ph_hi;
    XcdBarrier bar; bar.bar = (unsigned*)ctl + CW_BAR; bar.x = 0; bar.st = nullptr;
    if (hi - lo > 1) bar = xcd_barrier_post((unsigned*)ctl + CW_BAR, MISC + 8, wave);
#define IN(k) (lo <= (k) && (k) < hi)
#define SEAM(k) do { if (IN(k) && IN((k) + 1)) xcd_barrier(bar, wave); } while (0)

    float* mod = (float*)(ws + WS_MOD);
    float* bias2 = (float*)(ws + WS_BIAS2);
    int* blk_tab = (int*)(ws + WS_BLK);
    float* rope_cs = (float*)(ws + WS_ROPE);
    float* lat_parts = (float*)(ws + WS_LATP);
    float* rstd2 = (float*)(ws + WS_RSTD2);
    int* tope = (int*)(ws + WS_TOPE);
    float* gate = (float*)(ws + WS_GATE);
    int* rank = (int*)(ws + WS_RANK); int* destrow = (int*)(ws + WS_DEST); unsigned short* tokmap = (unsigned short*)(ws + WS_TOKMAP);
    bf16* wr_t = (bf16*)(ws + WS_WR); unsigned* as2 = (unsigned*)(ws + WS_AS2); float* x1parts = (float*)(ws + WS_X1P); unsigned char* h2b = ws + WS_H2;
    float* rowgate = (float*)(ws + WS_ROWGATE);
    bf16* Wt_in = (bf16*)(ws + WS_WIN); bf16* Wt_uq = (bf16*)(ws + WS_WUQ); bf16* Wt_ukv = (bf16*)(ws + WS_WUKV); bf16* Wt_out = (bf16*)(ws + WS_WOUT);
    bf16* Wt_gu = (bf16*)(ws + WS_WGU); bf16* Wt_d = (bf16*)(ws + WS_WD);
    bf16* hbuf = (bf16*)(ws + WS_H); bf16* proj = (bf16*)(ws + WS_PROJ); bf16* qraw = (bf16*)(ws + WS_QRAW); bf16* kvraw = (bf16*)(ws + WS_KVRAW);
    bf16* Kbuf = (bf16*)(ws + WS_K); unsigned char* mixed = ws + WS_MIXED; bf16* x1 = (bf16*)(ws + WS_X1);
    unsigned char* hs = ws + WS_HS; unsigned char* actb = ws + WS_ACT; unsigned char* ybuf = ws + WS_YBUF;

    if (IN(0)) for (int rep_ = 0; rep_ < REP_P0; ++rep_) { PH_IDS
        LAS float* red = (LAS float*)lds;
        for (int s = bid; s < 192; s += G) {
            const int j0 = s * 64, dsub = lane >> 4, c4 = (lane & 15) * 4;
            f32x4 a0 = {0.f, 0.f, 0.f, 0.f}, a1 = {0.f, 0.f, 0.f, 0.f};
            const float* wp = a.w_ada + (size_t)(wave * 256 + dsub) * (6 * DM) + j0 + c4;
#pragma unroll 8
            for (int i = 0; i < 64; ++i) { const int d = wave * 256 + 4 * i + dsub; const f32x4 w = *(const f32x4*)(wp + (size_t)(4 * i) * (6 * DM));
                float c0 = a.c[d], c1 = a.c[DM + d]; c0 = c0 / (1.0f + __expf(-c0)); c1 = c1 / (1.0f + __expf(-c1));
                a0 += w * c0; a1 += w * c1; }
#pragma unroll
            for (int k = 0; k < 4; ++k) { a0[k] += __shfl_xor(a0[k], 16); a0[k] += __shfl_xor(a0[k], 32); a1[k] += __shfl_xor(a1[k], 16); a1[k] += __shfl_xor(a1[k], 32); }
            if (lane < 16) {
#pragma unroll
                for (int k = 0; k < 4; ++k) { red[(wave * 2 + 0) * 64 + c4 + k] = a0[k]; red[(wave * 2 + 1) * 64 + c4 + k] = a1[k]; } }
            __syncthreads();
            if (tid < 128) { const int b = tid >> 6, j = tid & 63; float sum = 0.f;
#pragma unroll
                for (int w = 0; w < 8; ++w) sum += red[(w * 2 + b) * 64 + j];
                mod[b * (6 * DM) + j0 + j] = sum + a.b_ada[j0 + j]; }
            __syncthreads();
        }
        { u32x4* z = (u32x4*)(Wt_in + (size_t)DIN * DM); const int n16 = (DINP - DIN) * DM * 2 / 16;
          for (int i = bid * 512 + tid; i < n16; i += G * 512) z[i] = (u32x4){0u, 0u, 0u, 0u}; }
        for (int i = bid * 512 + tid; i < T * 32; i += G * 512) { const int t = i >> 5, f = i & 31;
            const float ang = (float)a.pos[t] * a.invf[f];
            const double rev = (double)ang * 0.15915494309189535; const float fr = (float)(rev - floor(rev));
            rope_cs[(size_t)t * 64 + f] = __builtin_amdgcn_cosf(fr); rope_cs[(size_t)t * 64 + 32 + f] = __builtin_amdgcn_sinf(fr); }
        __syncthreads();
        cvt_wave<false>(a, (LAS float*)lds + wave * (128 * 33), lane, gw, IT4, NGW);
        __syncthreads();
        bcvt_dma(a, lds, tid, bid + KATT * G, DT2, G);
    }
    SEAM(0);

    if (IN(1)) for (int rep_ = 0; rep_ < REP_P1; ++rep_) { PH_IDS
        if (bid == 0) {
            for (int o = wave; o < 64; o += 8) { const int b = o >> 5, e = o & 31; float s = 0.f;
                for (int d = lane; d < DM; d += 64) s += mod[b * (6 * DM) + 3 * DM + d] * a.router_w[(size_t)d * NE + e];
                s = wave_sum(s); if (lane == 0) bias2[o] = s + a.router_b[e]; }
        }
        for (int i = bid * 512 + tid; i < NB * DM; i += G * 512) { const int b = i / DM, d = i % DM; const float* mb = mod + b * (6 * DM);
            const float a2 = a.norm_ffn_g[d] * (1.0f + mb[4 * DM + d]);
            as2[i] = (cvtpk(a2, 0.f) & 0xffffu) | (cvtpk(mb[3 * DM + d], 0.f) << 16);
            for (int e = 0; e < NE; ++e) { const float w = a2 * a.router_w[(size_t)d * NE + e]; const unsigned hi = cvtpk(w, 0.f) & 0xffffu; const float lo = w - bf2f((unsigned short)hi);
                wr_t[((size_t)b * 64 + e) * DM + d] = (bf16)hi; wr_t[((size_t)b * 64 + 32 + e) * DM + d] = (bf16)(cvtpk(lo, 0.f) & 0xffffu); } }
        for (int r0 = gw * 16; r0 < T; r0 += NGW * 16) {
            const int b = r0 / SEQ; const float* mb = mod + b * (6 * DM);
            f32x4 ca[8], cs[8];
#pragma unroll
            for (int j = 0; j < 8; ++j) { const int d = j * 256 + lane * 4; const f32x4 g = *(const f32x4*)(a.norm_mix_g + d), sc = *(const f32x4*)(mb + DM + d);
                ca[j] = g * (sc + 1.0f); cs[j] = *(const f32x4*)(mb + d); }
            for (int r = r0; r < r0 + 16; r += 2) {
                const f32x4* xr = (const f32x4*)(a.x + (size_t)r * DM) + lane; const f32x4* xq = xr + DM / 4;
                f32x4 v[8], u[8]; float ss = 0.f, st = 0.f;
#pragma unroll
                for (int j = 0; j < 8; ++j) { v[j] = xr[64 * j]; u[j] = xq[64 * j]; }
#pragma unroll
                for (int j = 0; j < 8; ++j) { ss += (v[j].x * v[j].x + v[j].y * v[j].y) + (v[j].z * v[j].z + v[j].w * v[j].w); st += (u[j].x * u[j].x + u[j].y * u[j].y) + (u[j].z * u[j].z + u[j].w * u[j].w); }
#pragma unroll
                for (int o = 1; o < 64; o <<= 1) { ss += __shfl_xor(ss, o); st += __shfl_xor(st, o); }
                const float rs = 1.0f / sqrtf(ss * (1.0f / DM) + EPS), rt = 1.0f / sqrtf(st * (1.0f / DM) + EPS);
                u32x2* o8 = (u32x2*)(hbuf + (size_t)r * DM) + lane; u32x2* o9 = o8 + DM / 4;
#pragma unroll
                for (int j = 0; j < 8; ++j) { const f32x4 y = v[j] * rs * ca[j] + cs[j], z = u[j] * rt * ca[j] + cs[j]; o8[64 * j] = (u32x2){cvtpk(y.x, y.y), cvtpk(y.z, y.w)}; o9[64 * j] = (u32x2){cvtpk(z.x, z.y), cvtpk(z.z, z.w)}; }
            }
        }
    }
    SEAM(1);

    if (IN(2)) for (int rep_ = 0; rep_ < REP_P2; ++rep_) {
        pg8::Gemm g{hbuf, Wt_in, DM * 2, DM * 2, 0, nullptr}; pg8::TileOrder S; S.init(T / 256, DINP / 256, G, bid, nullptr);
        pg8::EpiBf16 E{proj, DINP, lat_parts, nullptr, 0, 0, 0.f};
        pg8::gemm_phase<false, false>(lds, g, S, E, wave);
    }
    SEAM(2);


    if (IN(4)) for (int rep_ = 0; rep_ < REP_P4; ++rep_) {
        { pg8::Gemm g{proj + C_QL, Wt_uq, DINP * 2, QLORA * 2, 0, nullptr}; pg8::TileOrder S; S.init(T / 256, (NH * DQK) / 256, G, bid, nullptr);
          pg8::EpiBf16 E{qraw, NH * DQK, nullptr, lat_parts, 0, 12, 1.0f / QLORA};
          pg8::gemm_phase<false, false>(lds, g, S, E, wave); }
        { pg8::Gemm g{proj + C_KVL, Wt_ukv, DINP * 2, KVLORA * 2, 0, nullptr}; pg8::TileOrder S; S.init(T / 256, (NH * 256) / 256, G, bid, nullptr);
          pg8::EpiBf16 E{kvraw, NH * 256, nullptr, lat_parts, 12, 8, 1.0f / KVLORA};
          pg8::gemm_phase<false, false>(lds, g, S, E, wave); }
    }
    SEAM(4);

    if (IN(5)) for (int rep_ = 0; rep_ < REP_P5; ++rep_) { PH_IDS
        for (int t0 = gw * 16; t0 < T; t0 += NGW * 16) {
            const int s0 = t0 % SEQ;
            {
                const int c0 = lane * 16;
                float w0[16], w1[16], w2[16], z1[16], z2[16];
#pragma unroll
                for (int q = 0; q < 4; ++q) { const f32x4 a0 = *(const f32x4*)(a.conv_w + c0 + 4 * q), a1 = *(const f32x4*)(a.conv_w + CONVD + c0 + 4 * q), a2 = *(const f32x4*)(a.conv_w + 2 * CONVD + c0 + 4 * q);
#pragma unroll
                    for (int j = 0; j < 4; ++j) { w0[4 * q + j] = a0[j]; w1[4 * q + j] = a1[j]; w2[4 * q + j] = a2[j]; } }
#pragma unroll
                for (int j = 0; j < 16; ++j) { z1[j] = 0.f; z2[j] = 0.f; }
                if (s0 >= 2) {
                    const bf16* p2 = proj + (size_t)(t0 - 2) * DINP; const bf16* p1 = proj + (size_t)(t0 - 1) * DINP;
                    float cg[16], uu[16];
                    unpack8(*(const bf16x8*)(p2 + C_C + c0), cg); unpack8(*(const bf16x8*)(p2 + C_C + c0 + 8), cg + 8); unpack8(*(const bf16x8*)(p2 + C_U + c0), uu); unpack8(*(const bf16x8*)(p2 + C_U + c0 + 8), uu + 8);
#pragma unroll
                    for (int j = 0; j < 16; ++j) z2[j] = cg[j] * uu[j];
                    unpack8(*(const bf16x8*)(p1 + C_C + c0), cg); unpack8(*(const bf16x8*)(p1 + C_C + c0 + 8), cg + 8); unpack8(*(const bf16x8*)(p1 + C_U + c0), uu); unpack8(*(const bf16x8*)(p1 + C_U + c0 + 8), uu + 8);
#pragma unroll
                    for (int j = 0; j < 16; ++j) z1[j] = cg[j] * uu[j];
                }
                for (int t = t0; t < t0 + 16; ++t) {
                    const bf16* pr = proj + (size_t)t * DINP;
                    float bg[16], cg[16], uu[16], y[16];
                    unpack8(*(const bf16x8*)(pr + C_B + c0), bg); unpack8(*(const bf16x8*)(pr + C_B + c0 + 8), bg + 8);
                    unpack8(*(const bf16x8*)(pr + C_C + c0), cg); unpack8(*(const bf16x8*)(pr + C_C + c0 + 8), cg + 8);
                    unpack8(*(const bf16x8*)(pr + C_U + c0), uu); unpack8(*(const bf16x8*)(pr + C_U + c0 + 8), uu + 8);
                    float ss = 0.f;
#pragma unroll
                    for (int j = 0; j < 16; ++j) { const float z0 = cg[j] * uu[j]; y[j] = bg[j] * (w0[j] * z2[j] + w1[j] * z1[j] + w2[j] * z0); ss += y[j] * y[j]; z2[j] = z1[j]; z1[j] = z0; }
                    ss += __shfl_xor(ss, 1); ss += __shfl_xor(ss, 2); ss += __shfl_xor(ss, 4);
                    const float rs = 1.0f / sqrtf(ss * (1.0f / 128.f) + EPS);
#pragma unroll
                    for (int j = 0; j < 16; ++j) y[j] *= rs * MSCALE;
                    *(u32x4*)(mixed + (size_t)t * DM + c0) = (u32x4){pg8::pk_fp8x4(y[0], y[1], y[2], y[3]), pg8::pk_fp8x4(y[4], y[5], y[6], y[7]), pg8::pk_fp8x4(y[8], y[9], y[10], y[11]), pg8::pk_fp8x4(y[12], y[13], y[14], y[15])};
                }
            }
            {
                const int hh = lane >> 3, sub = lane & 7;
                float gn[16], ga[4], gb[4];
#pragma unroll
                for (int q = 0; q < 4; ++q) { const f32x4 g4 = *(const f32x4*)(a.k_head_g + sub * 16 + 4 * q);
#pragma unroll
                    for (int j = 0; j < 4; ++j) gn[4 * q + j] = g4[j]; }
                { const f32x4 g4 = *(const f32x4*)(a.k_head_g + NOPE + sub * 4), g5 = *(const f32x4*)(a.k_head_g + NOPE + 32 + sub * 4);
#pragma unroll
                  for (int j = 0; j < 4; ++j) { ga[j] = g4[j]; gb[j] = g5[j]; } }
                for (int t = t0; t < t0 + 16; ++t) {
                    const bf16* kv = kvraw + (size_t)t * 2048 + hh * 256 + sub * 16;
                    const bf16* kp = proj + (size_t)t * DINP + C_KPE;
                    float kn[16]; unpack8(*(const bf16x8*)kv, kn); unpack8(*(const bf16x8*)(kv + 8), kn + 8);
                    const u32x2 wa = *(const u32x2*)(kp + sub * 4), wb = *(const u32x2*)(kp + 32 + sub * 4);
                    float xa[4] = {bf2f(wa.x & 0xffff), bf2f(wa.x >> 16), bf2f(wa.y & 0xffff), bf2f(wa.y >> 16)};
                    float xb[4] = {bf2f(wb.x & 0xffff), bf2f(wb.x >> 16), bf2f(wb.y & 0xffff), bf2f(wb.y >> 16)};
                    float ss = 0.f;
#pragma unroll
                    for (int j = 0; j < 16; ++j) ss += kn[j] * kn[j];
#pragma unroll
                    for (int j = 0; j < 4; ++j) ss += xa[j] * xa[j] + xb[j] * xb[j];
                    ss += __shfl_xor(ss, 1); ss += __shfl_xor(ss, 2); ss += __shfl_xor(ss, 4);
                    const float rs = 1.0f / sqrtf(ss * (1.0f / DQK) + EPS);
                    const f32x4 cc = *(const f32x4*)(rope_cs + (size_t)t * 64 + sub * 4), sn = *(const f32x4*)(rope_cs + (size_t)t * 64 + 32 + sub * 4);
#pragma unroll
                    for (int j = 0; j < 16; ++j) kn[j] *= rs * gn[j];
                    float o1[4], o2[4];
#pragma unroll
                    for (int j = 0; j < 4; ++j) { const float p = xa[j] * rs * ga[j], q = xb[j] * rs * gb[j]; o1[j] = p * cc[j] - q * sn[j]; o2[j] = q * cc[j] + p * sn[j]; }
                    bf16* ko = Kbuf + (size_t)t * 1536 + hh * DQK;
                    *(bf16x8*)(ko + sub * 16) = pack8f(kn); *(bf16x8*)(ko + sub * 16 + 8) = pack8f(kn + 8);
                    *(u32x2*)(ko + NOPE + sub * 4) = (u32x2){cvtpk(o1[0], o1[1]), cvtpk(o1[2], o1[3])};
                    *(u32x2*)(ko + NOPE + 32 + sub * 4) = (u32x2){cvtpk(o2[0], o2[1]), cvtpk(o2[2], o2[3])};
                }
            }
        }
    }
    SEAM(5);

    if (IN(6)) for (int rep_ = 0; rep_ < REP_ATT; ++rep_) {
        const att::Tensors X{qraw, Kbuf, kvraw + 128, mixed + CONVD, rope_cs, a.q_head_g};
        bool att_fast; { const int ln_ = lane_id(); float gq = 0.f, gk = 0.f;
            for (int i = ln_; i < DQK; i += 64) { gq = fmaxf(gq, fabsf(a.q_head_g[i])); gk = fmaxf(gk, fabsf(a.k_head_g[i])); }
#pragma unroll
            for (int o = 1; o < 64; o <<= 1) { gq = fmaxf(gq, __shfl_xor(gq, o)); gk = fmaxf(gk, __shfl_xor(gk, o)); }
            att_fast = __builtin_amdgcn_readfirstlane((int)(20.0f * gq * gk <= 64.0f)) != 0; }
        att::WStream W{a.w_gu, a.w_down, ws + WS_WGU, ws + WS_WD, bid, G, 0, 0, nullptr, 0, nullptr};
        int katt; { const int avail = bid < DT2 ? (DT2 - bid + G - 1) / G : 0; katt = avail < KATT ? avail : KATT; }
        W.total = katt * 4;
        for (int i = bid; i < 512; i += G) {
            const int bh = (i >> 8) * 8 + (i & 7), xq = (i & 255) >> 3;
            for (int u = 0; u < 2; ++u) { if (att_fast) att::attn_unit<true>(X, bh >> 3, bh & 7, u ? xq : 63 - xq, (LAS char*)lds, W, wave); else att::attn_unit<false>(X, bh >> 3, bh & 7, u ? xq : 63 - xq, (LAS char*)lds, W, wave); }
        }
        asm volatile("s_waitcnt vmcnt(0)" ::: "memory");
        __syncthreads();
        { int tz = TID_NOW(wave); asm volatile("" : "+v"(tz));
          int kd = W.pos >= 3 ? (W.pos - 3) >> 2 : 0; kd = kd < katt ? kd : katt;
          bcvt_dma(a, lds, tz, bid + kd * G, (bid + KATT * G < DT2) ? bid + KATT * G : DT2, G); }
    }
    SEAM(6);

    if (IN(7)) for (int rep_ = 0; rep_ < REP_P7; ++rep_) {
        pg8::Gemm g{mixed, Wt_out, DM, DM, 0, nullptr}; pg8::TileOrder S; S.init(T / 256, DM / 256, G, bid, nullptr);
        pg8::EpiResF32 E{a.x, x1, mod + 2 * DM, x1parts, 1.0f / (WSCALE * MSCALE)};
        pg8::gemm_phase<true, false>(lds, g, S, E, wave);
    }
    SEAM(7);

    if (IN(8)) for (int rep_ = 0; rep_ < REP_P8; ++rep_) { PH_IDS
        const int sh_ = rep_ ? 64 : 0; int* tope_ = rep_ ? (int*)(ws + WS_HS) : tope; float* gate_ = rep_ ? (float*)(ws + WS_HS + MiB) : gate; int* rank_ = rep_ ? (int*)(ws + WS_HS + 2 * MiB) : rank;
        LAS unsigned char* la = lds;
        LAS unsigned char* lb = lds + 32768;
        LAS float* lrs = (LAS float*)(lds + 49152);
        LAS float* lg = lrs + 128;
        LAS int* lcnt = (LAS int*)(lg + 128 * 33);
        const int fr = lane & 15, fq = lane >> 4;
        if (rep_ == 0) for (int i = bid * 512 + tid; i < PROWS / 8; i += G * 512) ((u32x4*)tokmap)[i] = (u32x4){0u, 0u, 0u, 0u};
        for (int blk = bid; blk < T / 128; blk += G) {
            const int tok0 = blk * 128, b = tok0 / SEQ;
            if (tid < 64) lcnt[tid] = 0;
            if (tid < 128) { const float* pp = x1parts + (size_t)(tok0 + tid) * 32; float ss = 0.f;
#pragma unroll
                for (int i = 0; i < 32; i += 4) { const f32x4 v = *(const f32x4*)(pp + i); ss += (v[0] + v[1]) + (v[2] + v[3]); }
                lrs[tid] = 1.0f / sqrtf(ss * (1.0f / DM) + EPS); }
            __syncthreads();
            const int xt = tid >> 2, xp = tid & 3;
            const int wn = tid >> 3, wc8 = tid & 7;
            const float rs_st = lrs[xt];
            const bf16* xsrc = x1 + (size_t)(tok0 + xt) * DM + xp * 16;
            const bf16* wsrc = wr_t + ((size_t)b * 64 + wn) * DM + wc8 * 8;
            const unsigned* asrc = as2 + (size_t)b * DM + xp * 16;
            unsigned char* hdst = h2b + (size_t)(tok0 + xt) * DM + xp * 16;
            const int aw0 = xt * 128 + (((2 * xp) ^ ((xt >> 1) & 7)) << 4), aw1 = xt * 128 + (((2 * xp + 1) ^ ((xt >> 1) & 7)) << 4);
            const int bw = wn * 128 + ((wc8 ^ ((wn >> 1) & 7)) << 4);
            const int arow = (wave * 16 + fr) * 128, asw = ((wave * 16 + fr) >> 1) & 7;
            const int bsw = (fr >> 1) & 7;
            f32x4 acc[4];
#pragma unroll
            for (int i = 0; i < 4; ++i) acc[i] = (f32x4){0.f, 0.f, 0.f, 0.f};
            bf16x8 xa0, xb0, wv0, xa1, xb1, wv1, xa2, xb2, wv2, xa3, xb3, wv3; u32x4 av0[4], av1[4];
#define P8_LDX(CH, XA, XB, WV) do { XA = *(const bf16x8*)(xsrc + (CH) * 64); XB = *(const bf16x8*)(xsrc + (CH) * 64 + 8); WV = *(const bf16x8*)(wsrc + (CH) * 64); } while (0)
#define P8_LDA(CH, AV) do { _Pragma("unroll") for (int q = 0; q < 4; ++q) AV[q] = *(const u32x4*)(asrc + (CH) * 64 + 4 * q); } while (0)
#define P8_STEP(CH, XA, XB, WV, AV) do { \
                LAS unsigned char* ab = la + ((CH) & 1) * 16384; LAS unsigned char* bb = lb + ((CH) & 1) * 8192; \
                *(LAS bf16x8*)(ab + aw0) = XA; *(LAS bf16x8*)(ab + aw1) = XB; *(LAS bf16x8*)(bb + bw) = WV; \
                if (rep_ == 0) {                                    \
                    float xf[16]; unpack8(XA, xf); unpack8(XB, xf + 8); \
                    u32x4 hw; \
                    _Pragma("unroll") for (int q = 0; q < 4; ++q) { const u32x4 av = AV[q]; float y[4]; \
                        _Pragma("unroll") for (int j = 0; j < 4; ++j) y[j] = (xf[4 * q + j] * rs_st * bf2f((unsigned short)(av[j] & 0xffffu)) + bf2f((unsigned short)(av[j] >> 16))) * HSCALE; \
                        hw[q] = pg8::pk_fp8x4(y[0], y[1], y[2], y[3]); } \
                    *(u32x4*)(hdst + (CH) * 64) = hw; \
                } \
                if ((CH) + 4 < 32) P8_LDX((CH) + 4, XA, XB, WV); \
                if ((CH) + 2 < 32) P8_LDA((CH) + 2, AV); \
                __syncthreads(); \
                _Pragma("unroll") for (int ks = 0; ks < 2; ++ks) { \
                    const bf16x8 af = *(const LAS bf16x8*)(ab + arow + (((ks * 4 + fq) ^ asw) << 4)); \
                    _Pragma("unroll") for (int ng = 0; ng < 4; ++ng) { const bf16x8 bf = *(const LAS bf16x8*)(bb + (ng * 16 + fr) * 128 + (((ks * 4 + fq) ^ bsw) << 4)); \
                        acc[ng] = __builtin_amdgcn_mfma_f32_16x16x32_bf16(bf, af, acc[ng], 0, 0, 0); } \
                } } while (0)
            P8_LDX(0, xa0, xb0, wv0); P8_LDA(0, av0); P8_LDX(1, xa1, xb1, wv1); P8_LDA(1, av1); P8_LDX(2, xa2, xb2, wv2); P8_LDX(3, xa3, xb3, wv3);
            for (int ch = 0; ch < 32; ch += 4) { P8_STEP(ch, xa0, xb0, wv0, av0); P8_STEP(ch + 1, xa1, xb1, wv1, av1); P8_STEP(ch + 2, xa2, xb2, wv2, av0); P8_STEP(ch + 3, xa3, xb3, wv3, av1); }
#undef P8_LDX
#undef P8_LDA
#undef P8_STEP
            { const int tl = wave * 16 + fr; const float rs = lrs[tl];
#pragma unroll
              for (int r = 0; r < 4; ++r) { const int e0 = 4 * fq + r, e1 = 16 + 4 * fq + r;
                  lg[tl * 33 + e0] = (acc[0][r] + acc[2][r]) * rs + bias2[b * NE + e0]; lg[tl * 33 + e1] = (acc[1][r] + acc[3][r]) * rs + bias2[b * NE + e1]; } }
            __syncthreads();
            int te[4], lr[4]; float tv[4];
            if (tid < 128) {
                float v[32];
#pragma unroll
                for (int e = 0; e < 32; ++e) v[e] = lg[tid * 33 + e];
#pragma unroll
                for (int k = 0; k < 4; ++k) { float best = v[0]; int bi = 0;
#pragma unroll
                    for (int e = 1; e < 32; ++e) { if (v[e] > best) { best = v[e]; bi = e; } }
                    te[k] = bi; tv[k] = best;
#pragma unroll
                    for (int e = 0; e < 32; ++e) if (e == bi) v[e] = -__builtin_inff(); }
                float den = 0.f, ex[4];
#pragma unroll
                for (int k = 0; k < 4; ++k) { ex[k] = __expf(tv[k] - tv[0]); den += ex[k]; }
                const float inv = 1.0f / den;
#pragma unroll
                for (int k = 0; k < 4; ++k) { tv[k] = ex[k] * inv; lr[k] = atomicAdd((int*)(lcnt + te[k]), 1); }
            }
            __syncthreads();
            if (tid < 32) lcnt[32 + tid] = (int)__hip_atomic_fetch_add((unsigned*)ctl + CW_CNT + sh_ + tid, (unsigned)lcnt[tid], __ATOMIC_RELAXED, __HIP_MEMORY_SCOPE_AGENT);
            __syncthreads();
            if (tid < 128) { const int t = tok0 + tid;
#pragma unroll
                for (int k = 0; k < 4; ++k) { tope_[t * 4 + k] = te[k]; gate_[t * 4 + k] = tv[k]; rank_[t * 4 + k] = lcnt[32 + te[k]] + lr[k]; } }
            __syncthreads();
        }
    }
    SEAM(8);

    if (IN(9)) for (int rep_ = 0; rep_ < REP_P9; ++rep_) { PH_IDS
        LAS int* ps = (LAS int*)lds;
        if (tid == 0) { int run = 0;
            for (int e = 0; e < NE; ++e) { ps[e] = run; const int c = (int)ld_agent((const unsigned*)ctl + CW_CNT + e); run += ((c + 255) >> 8) << 8; }
            ps[32] = run; }
        __syncthreads();
        if (bid == 0) { const int nblk = ps[32] >> 8;
            for (int r = tid; r < NBLK_MAX; r += 512) { int e = 0;
                for (int q = 1; q < NE; ++q) if (ps[q] <= r * 256) e = q;
                blk_tab[r] = (r < nblk) ? e : 0; }
            if (tid == 0) blk_tab[1023] = nblk; }
        for (int i = (bid * 512 + tid); i < T * TOPK; i += G * 512) { const int d_ = ps[tope[i]] + rank[i]; rowgate[d_] = gate[i]; destrow[i] = d_; tokmap[d_] = (unsigned short)(i >> 2); }
    }
    SEAM(9);

    if (IN(10)) for (int rep_ = 0; rep_ < REP_MOE1; ++rep_) {
        const int nblk = __builtin_amdgcn_readfirstlane((int)ld_agent((const unsigned*)blk_tab + 1023));
        pg8::Gemm g{h2b, Wt_gu, DM, DM, (size_t)(2 * FF) * DM, tokmap}; pg8::TileOrder S; S.init(nblk, (2 * FF) / 256, G, bid, blk_tab);
        pg8::EpiSwiglu E{actb, a.b_gu, 1.0f / (WSCALE * HSCALE)};
        pg8::gemm_phase<true, true>(lds, g, S, E, wave);
    }
    SEAM(10);

    if (IN(11)) for (int rep_ = 0; rep_ < REP_MOE2; ++rep_) {
        const int nblk = __builtin_amdgcn_readfirstlane((int)ld_agent((const unsigned*)blk_tab + 1023));
        pg8::Gemm g{actb, Wt_d, FF, FF, (size_t)DM * FF, nullptr}; pg8::TileOrder S; S.init(nblk, DM / 256, G, bid, blk_tab);
        pg8::EpiDown E{ybuf, a.b_down, rowgate, 1.0f / (WSCALE * ASCALE)};
        pg8::gemm_phase<true, false>(lds, g, S, E, wave);
    }
    SEAM(11);

    if (IN(12)) for (int rep_ = 0; rep_ < REP_P12; ++rep_) { PH_IDS
        for (int t = gw; t < T; t += NGW) {
            const int b = t / SEQ; const float* gf = mod + b * (6 * DM) + 5 * DM;
            int dst[4];
#pragma unroll
            for (int k = 0; k < 4; ++k) dst[k] = destrow[t * 4 + k];
#pragma unroll
            for (int j = 0; j < 4; ++j) { const int d = j * 512 + lane * 8;
                float s[8] = {0.f, 0.f, 0.f, 0.f, 0.f, 0.f, 0.f, 0.f};
#pragma unroll
                for (int k = 0; k < 4; ++k) { const u32x2 w = *(const u32x2*)(ybuf + (size_t)dst[k] * DM + d);
                    const f32x2 f0 = __builtin_amdgcn_cvt_pk_f32_fp8((int)w.x, false), f1 = __builtin_amdgcn_cvt_pk_f32_fp8((int)w.x, true), f2 = __builtin_amdgcn_cvt_pk_f32_fp8((int)w.y, false), f3 = __builtin_amdgcn_cvt_pk_f32_fp8((int)w.y, true);
                    s[0] += f0.x; s[1] += f0.y; s[2] += f1.x; s[3] += f1.y; s[4] += f2.x; s[5] += f2.y; s[6] += f3.x; s[7] += f3.y; }
#pragma unroll
                for (int q = 0; q < 8; ++q) s[q] *= (1.0f / YSCALE);
                float xf[8]; unpack8(*(const bf16x8*)(x1 + (size_t)t * DM + d), xf);
                const f32x4 xa = {xf[0], xf[1], xf[2], xf[3]}, xb = {xf[4], xf[5], xf[6], xf[7]};
                const f32x4 ga = *(const f32x4*)(gf + d), gb = *(const f32x4*)(gf + d + 4);
                *(f32x4*)(a.out + (size_t)t * DM + d) = xa + ga * (f32x4){s[0], s[1], s[2], s[3]};
                *(f32x4*)(a.out + (size_t)t * DM + d + 4) = xb + gb * (f32x4){s[4], s[5], s[6], s[7]}; }
        }
    }
#undef IN
#undef SEAM
}

extern "C" void kernel_launch(void* const* d_in, const int* in_sizes, int n_in, void* d_out, int out_size, void* d_ws, size_t ws_size, hipStream_t stream) {
    static int grid = 0;
    static float invf[32];
    if (grid == 0) {
        if (n_in != 24 || out_size != T * DM || ws_size < WS_END) { fprintf(stderr, "kernel_launch: unexpected shapes (n_in %d out %d ws %zu)\n", n_in, out_size, ws_size); grid = -1; return; }
        int dev = 0, cus = 0;
        if (hipGetDevice(&dev) != hipSuccess || hipDeviceGetAttribute(&cus, hipDeviceAttributeMultiprocessorCount, dev) != hipSuccess) { grid = -1; return; }
        if (hipFuncSetAttribute((const void*)fwd, hipFuncAttributeMaxDynamicSharedMemorySize, LDS_BYTES) != hipSuccess) { fprintf(stderr, "kernel_launch: hipFuncSetAttribute failed\n"); grid = -1; return; }
        int per_cu = 0;
        (void)hipOccupancyMaxActiveBlocksPerMultiprocessor(&per_cu, (const void*)fwd, 512, LDS_BYTES);
        (void)hipGetLastError();
        if (per_cu < 1) fprintf(stderr, "kernel_launch: occupancy query reports %d\n", per_cu);
        grid = cus;
        for (int i = 0; i < 32; ++i) invf[i] = powf(10000.0f, -(float)i / 32.0f);
    }
    if (grid < 0) return;
    (void)hipMemsetAsync((char*)d_ws + WS_CTL, 0, CTL_ZERO_BYTES, stream);
    Args a{};
    a.x = (const float*)d_in[0]; a.c = (const float*)d_in[1]; a.pos = (const int*)d_in[2]; a.w_ada = (const float*)d_in[3]; a.b_ada = (const float*)d_in[4]; a.norm_mix_g = (const float*)d_in[5];
    a.w_in = (const float*)d_in[6]; a.conv_w = (const float*)d_in[7]; a.q_lat_g = (const float*)d_in[8]; a.w_uq = (const float*)d_in[9]; a.kv_lat_g = (const float*)d_in[10]; a.w_ukv = (const float*)d_in[11];
    a.q_head_g = (const float*)d_in[12]; a.k_head_g = (const float*)d_in[13]; a.conv_out_g = (const float*)d_in[14]; a.mla_out_g = (const float*)d_in[15]; a.w_out = (const float*)d_in[16];
    a.norm_ffn_g = (const float*)d_in[17]; a.router_w = (const float*)d_in[18]; a.router_b = (const float*)d_in[19]; a.w_gu = (const float*)d_in[20]; a.b_gu = (const float*)d_in[21];
    a.w_down = (const float*)d_in[22]; a.b_down = (const float*)d_in[23];
    a.out = (float*)d_out; a.ws = (unsigned char*)d_ws;
    for (int i = 0; i < 32; ++i) a.invf[i] = invf[i];
#if MK_ONE_LAUNCH
    a.ph_lo = 0; a.ph_hi = NPH;
    hipLaunchKernelGGL(fwd, dim3(grid), dim3(512), LDS_BYTES, stream, a);
#else
    for (int p = 0; p < NPH; ++p) { a.ph_lo = p; a.ph_hi = p + 1; hipLaunchKernelGGL(fwd, dim3(grid), dim3(512), LDS_BYTES, stream, a); }
#endif
}
```
